# Optimizing an MI355X kernel written in HIP

```python
import math
import jax, jax.numpy as jnp
from jax import lax
import numpy as np

D_MODEL = 1024
BATCH = 32
SEQ = 2048
DEPTH = 2

GRID_W = 64
CTX_LEN = 256
EPS = 1e-6

D_MIX = D_MODEL
A_WIDTH = D_MIX // 4
A_HEADS = 4
A_HEAD_DIM = A_WIDTH // A_HEADS
CHUNK = 128
B_WIDTH = D_MIX // 2
SSM_GROUP = 16
SSM_GROUPS = B_WIDTH // SSM_GROUP
SSM_STATE = 64
C_WIDTH = D_MIX - A_WIDTH - B_WIDTH
POOL_WINDOWS = (2, 4, 8, 16)
POOL_GROUP = C_WIDTH // len(POOL_WINDOWS)
D_IN = 2 * A_WIDTH + B_WIDTH + C_WIDTH
D_FF = ((-(-8 * D_MODEL // 3) + 255) // 256) * 256

kernel_name = "hybrid_gmlp_s5_pool_dit_prefix"


def rms_norm(x, g):
    xf = x.astype(jnp.float32)
    y = xf * lax.rsqrt(jnp.mean(xf * xf, axis=-1, keepdims=True) + EPS)
    return (y * g.astype(jnp.float32)).astype(x.dtype)


def layer_norm(x):
    xf = x.astype(jnp.float32)
    mu = jnp.mean(xf, axis=-1, keepdims=True)
    var = jnp.mean(jnp.square(xf - mu), axis=-1, keepdims=True)
    return ((xf - mu) * lax.rsqrt(var + EPS)).astype(x.dtype)


def modulate(h, shift, scale):
    return h * (1 + scale) + shift


def sincos_2d(rows, cols, dim):
    quarter = dim // 4
    omega = 1.0 / (10000.0 ** (jnp.arange(quarter, dtype=jnp.float32) / quarter))
    r = jnp.arange(rows, dtype=jnp.float32)[:, None] * omega
    cc = jnp.arange(cols, dtype=jnp.float32)[:, None] * omega
    er = jnp.concatenate([jnp.sin(r), jnp.cos(r)], axis=-1)
    ec = jnp.concatenate([jnp.sin(cc), jnp.cos(cc)], axis=-1)
    pe = jnp.concatenate([jnp.broadcast_to(er[:, None, :], (rows, cols, dim // 2)),
                          jnp.broadcast_to(ec[None, :, :], (rows, cols, dim // 2))], axis=-1)
    return pe.reshape(rows * cols, dim)


def spatial_gating(z, w_s, b_s):
    bsz, n, _ = z.shape
    z = jax.nn.gelu(z)
    u, v = jnp.split(z, 2, axis=-1)
    v = layer_norm(v.reshape(bsz, n // CHUNK, CHUNK, A_HEADS, A_HEAD_DIM))
    s = jnp.einsum('hpq,bkqhd->bkphd', w_s, v) + b_s.T[None, None, :, :, None]
    return u * s.reshape(bsz, n, A_WIDTH)


def ssm_discretize(lam_re, lam_im, log_dt, b_re, b_im):
    lam = lax.complex(lam_re.astype(jnp.float32), lam_im.astype(jnp.float32))
    dt = jnp.exp(log_dt.astype(jnp.float32))[:, None]
    lam_bar = jnp.exp(lam * dt)
    b = lax.complex(b_re.astype(jnp.float32), b_im.astype(jnp.float32))
    b_bar = ((lam_bar - 1.0) / lam)[..., None] * b
    return lam_bar, b_bar


def diag_scan(lam_bar, bu, h0, reverse):
    if h0 is not None:
        edge = bu.shape[1] - 1 if reverse else 0
        bu = bu.at[:, edge].add(lam_bar * h0)
    a = jnp.broadcast_to(lam_bar, bu.shape)

    def combine(e1, e2):
        a1, b1 = e1
        a2, b2 = e2
        return a1 * a2, a2 * b1 + b2

    _, h = lax.associative_scan(combine, (a, bu), reverse=reverse, axis=1)
    return h


def ssm_mixer(u_lat, u_ctx, lam_re, lam_im, log_dt, b_re, b_im, c_re, c_im, d, glu_w, glu_b, need_ctx):
    def groups(u):
        return u.reshape(u.shape[0], u.shape[1], SSM_GROUPS, SSM_GROUP).astype(jnp.float32)

    g_lat, g_ctx = groups(u_lat), groups(u_ctx)
    df = d.astype(jnp.float32)
    y_lat = df * g_lat
    y_ctx = df * g_ctx if need_ctx else None
    for k, reverse in enumerate((False, True)):
        lam_bar, b_bar = ssm_discretize(lam_re[k], lam_im[k], log_dt[k], b_re[k], b_im[k])
        cm = lax.complex(c_re[k].astype(jnp.float32), c_im[k].astype(jnp.float32))
        bu_ctx = jnp.einsum('blgh,gph->blgp', g_ctx.astype(jnp.complex64), b_bar)
        h_ctx = diag_scan(lam_bar, bu_ctx, None, reverse)
        h_end = h_ctx[:, 0] if reverse else h_ctx[:, -1]
        bu_lat = jnp.einsum('blgh,gph->blgp', g_lat.astype(jnp.complex64), b_bar)
        h_lat = diag_scan(lam_bar, bu_lat, h_end, reverse)
        y_lat = y_lat + jnp.einsum('ghp,blgp->blgh', cm, h_lat).real
        if need_ctx:
            y_ctx = y_ctx + jnp.einsum('ghp,blgp->blgh', cm, h_ctx).real

    def glu(y, dtype):
        g = jax.nn.gelu(y.reshape(y.shape[0], y.shape[1], B_WIDTH)).astype(dtype)
        return g * jax.nn.sigmoid(g @ glu_w + glu_b)

    out_lat = glu(y_lat, u_lat.dtype)
    out_ctx = glu(y_ctx, u_ctx.dtype) if need_ctx else None
    return out_lat, out_ctx


def window_mean(x, w):
    n = x.shape[-2]
    cs = jnp.cumsum(x.astype(jnp.float32), axis=-2)
    cs = jnp.concatenate([jnp.zeros_like(cs[..., :1, :]), cs], axis=-2)
    t = np.arange(n)
    lo = np.clip(t - w // 2, 0, n)
    hi = np.clip(t - w // 2 + w, 0, n)
    cnt = (hi - lo).astype(np.float32)[:, None]
    return ((jnp.take(cs, hi, axis=-2) - jnp.take(cs, lo, axis=-2)) / cnt).astype(x.dtype)


def pool_mixer(p, pool_w, pool_scale, rows):
    bsz, n, _ = p.shape
    outs = []
    for i, w in enumerate(POOL_WINDOWS):
        pg = p[..., i * POOL_GROUP:(i + 1) * POOL_GROUP]
        if rows is None:
            m = window_mean(pg, w)
        else:
            m = window_mean(pg.reshape(bsz, rows, GRID_W, POOL_GROUP), w).reshape(bsz, n, POOL_GROUP)
        outs.append((m - pg) @ pool_w[i])
    return jnp.concatenate(outs, axis=-1) * pool_scale


def mixing_sublayer(h_lat, h_ctx, rows, need_ctx, w_in, w_out, sgu_w, sgu_b,
                    lam_re, lam_im, log_dt, b_re, b_im, c_re, c_im, d, glu_w, glu_b,
                    pool_w, pool_scale):
    b_lo, b_hi = 2 * A_WIDTH, 2 * A_WIDTH + B_WIDTH
    z_lat = h_lat @ w_in
    if need_ctx:
        z_ctx = h_ctx @ w_in
        u_ctx = z_ctx[..., b_lo:b_hi]
    else:
        u_ctx = h_ctx @ w_in[:, b_lo:b_hi]
    a_lat = spatial_gating(z_lat[..., :b_lo], sgu_w, sgu_b)
    s_lat, s_ctx = ssm_mixer(z_lat[..., b_lo:b_hi], u_ctx, lam_re, lam_im, log_dt, b_re, b_im,
                             c_re, c_im, d, glu_w, glu_b, need_ctx)
    p_lat = pool_mixer(z_lat[..., b_hi:], pool_w, pool_scale, rows)
    m_lat = jnp.concatenate([a_lat, s_lat, p_lat], axis=-1) @ w_out
    m_ctx = None
    if need_ctx:
        a_ctx = spatial_gating(z_ctx[..., :b_lo], sgu_w, sgu_b)
        p_ctx = pool_mixer(z_ctx[..., b_hi:], pool_w, pool_scale, None)
        m_ctx = jnp.concatenate([a_ctx, s_ctx, p_ctx], axis=-1) @ w_out
    return m_lat, m_ctx


def swiglu(h, w_gate, w_up, w_down):
    return (jax.nn.silu(h @ w_gate) * (h @ w_up)) @ w_down


def setup_inputs(seed: int = 0) -> dict:
    key = jax.random.key(seed)
    ks = jax.random.split(key, 32)
    f32 = jnp.float32

    def nrm(k, shape, scale):
        return jax.random.normal(k, shape, f32) * scale

    lam_im0 = math.pi * jnp.arange(SSM_STATE, dtype=f32)
    return {
        "x": nrm(ks[0], (BATCH, SEQ, D_MODEL), 1.0),
        "c": nrm(ks[1], (BATCH, D_MODEL), 1.0),
        "ctx": nrm(ks[2], (BATCH, CTX_LEN, D_MODEL), 1.0),
        "c_ctx": nrm(ks[3], (D_MODEL,), 1.0),
        "w_mod": nrm(ks[4], (DEPTH, D_MODEL, 6 * D_MODEL), 0.5 * D_MODEL ** -0.5),
        "b_mod": nrm(ks[5], (DEPTH, 6 * D_MODEL), 0.02),
        "norm_mix_pre": 1.0 + nrm(ks[6], (DEPTH, D_MODEL), 0.1),
        "norm_mix_post": 1.0 + nrm(ks[7], (DEPTH, D_MODEL), 0.1),
        "norm_ffn_pre": 1.0 + nrm(ks[8], (DEPTH, D_MODEL), 0.1),
        "norm_ffn_post": 1.0 + nrm(ks[9], (DEPTH, D_MODEL), 0.1),
        "w_in": nrm(ks[10], (DEPTH, D_MODEL, D_IN), D_MODEL ** -0.5),
        "w_out": nrm(ks[11], (DEPTH, D_MIX, D_MODEL), D_MIX ** -0.5),
        "sgu_w": nrm(ks[12], (DEPTH, A_HEADS, CHUNK, CHUNK), CHUNK ** -0.5),
        "sgu_b": 1.0 + nrm(ks[13], (DEPTH, A_HEADS, CHUNK), 0.1),
        "ssm_lam_re": -0.5 + nrm(ks[14], (DEPTH, 2, SSM_GROUPS, SSM_STATE), 0.01),
        "ssm_lam_im": lam_im0 + nrm(ks[15], (DEPTH, 2, SSM_GROUPS, SSM_STATE), 0.01),
        "ssm_log_dt": jax.random.uniform(ks[16], (DEPTH, 2, SSM_GROUPS), f32,
                                         minval=math.log(1e-3), maxval=math.log(1e-1)),
        "ssm_b_re": nrm(ks[17], (DEPTH, 2, SSM_GROUPS, SSM_STATE, SSM_GROUP), (2 * SSM_GROUP) ** -0.5),
        "ssm_b_im": nrm(ks[18], (DEPTH, 2, SSM_GROUPS, SSM_STATE, SSM_GROUP), (2 * SSM_GROUP) ** -0.5),
        "ssm_c_re": nrm(ks[19], (DEPTH, 2, SSM_GROUPS, SSM_GROUP, SSM_STATE), SSM_STATE ** -0.5),
        "ssm_c_im": nrm(ks[20], (DEPTH, 2, SSM_GROUPS, SSM_GROUP, SSM_STATE), SSM_STATE ** -0.5),
        "ssm_d": nrm(ks[21], (DEPTH, SSM_GROUPS, SSM_GROUP), 1.0),
        "glu_w": nrm(ks[22], (DEPTH, B_WIDTH, B_WIDTH), B_WIDTH ** -0.5),
        "glu_b": nrm(ks[23], (DEPTH, B_WIDTH), 0.02),
        "pool_w": nrm(ks[24], (DEPTH, len(POOL_WINDOWS), POOL_GROUP, POOL_GROUP), POOL_GROUP ** -0.5),
        "pool_scale": 1.0 + nrm(ks[25], (DEPTH, C_WIDTH), 0.1),
        "ffn_w_gate": nrm(ks[26], (DEPTH, D_MODEL, D_FF), D_MODEL ** -0.5),
        "ffn_w_up": nrm(ks[27], (DEPTH, D_MODEL, D_FF), D_MODEL ** -0.5),
        "ffn_w_down": nrm(ks[28], (DEPTH, D_FF, D_MODEL), D_FF ** -0.5),
    }


def reference(x, c, ctx, c_ctx, w_mod, b_mod, norm_mix_pre, norm_mix_post, norm_ffn_pre, norm_ffn_post,
              w_in, w_out, sgu_w, sgu_b, ssm_lam_re, ssm_lam_im, ssm_log_dt, ssm_b_re, ssm_b_im,
              ssm_c_re, ssm_c_im, ssm_d, glu_w, glu_b, pool_w, pool_scale,
              ffn_w_gate, ffn_w_up, ffn_w_down):
    n_lat = x.shape[1]
    ROWS = n_lat // GRID_W
    x_lat = x + sincos_2d(ROWS, GRID_W, x.shape[-1]).astype(x.dtype)[None]
    x_ctx = ctx
    for i in range(DEPTH):
        need_ctx = i < DEPTH - 1
        mod_lat = jax.nn.silu(c) @ w_mod[i] + b_mod[i]
        mod_ctx = jax.nn.silu(c_ctx) @ w_mod[i] + b_mod[i]
        sh1, sc1, g1, sh2, sc2, g2 = [m[:, None, :] for m in jnp.split(mod_lat, 6, axis=-1)]
        csh1, csc1, cg1, csh2, csc2, cg2 = jnp.split(mod_ctx, 6, axis=-1)

        h_lat = modulate(rms_norm(x_lat, norm_mix_pre[i]), sh1, sc1)
        h_ctx = modulate(rms_norm(x_ctx, norm_mix_pre[i]), csh1, csc1)
        m_lat, m_ctx = mixing_sublayer(h_lat, h_ctx, ROWS, need_ctx, w_in[i], w_out[i], sgu_w[i], sgu_b[i],
                                       ssm_lam_re[i], ssm_lam_im[i], ssm_log_dt[i], ssm_b_re[i], ssm_b_im[i],
                                       ssm_c_re[i], ssm_c_im[i], ssm_d[i], glu_w[i], glu_b[i],
                                       pool_w[i], pool_scale[i])
        x_lat = x_lat + g1 * rms_norm(m_lat, norm_mix_post[i])
        f_lat = swiglu(modulate(rms_norm(x_lat, norm_ffn_pre[i]), sh2, sc2),
                       ffn_w_gate[i], ffn_w_up[i], ffn_w_down[i])
        x_lat = x_lat + g2 * rms_norm(f_lat, norm_ffn_post[i])
        if need_ctx:
            x_ctx = x_ctx + cg1 * rms_norm(m_ctx, norm_mix_post[i])
            f_ctx = swiglu(modulate(rms_norm(x_ctx, norm_ffn_pre[i]), csh2, csc2),
                           ffn_w_gate[i], ffn_w_up[i], ffn_w_down[i])
            x_ctx = x_ctx + cg2 * rms_norm(f_ctx, norm_ffn_post[i])
    return x_lat
```

```cpp
#include <hip/hip_runtime.h>
#include <hip/hip_cooperative_groups.h>
#include <cstdio>
#include <cstdint>
namespace cg = cooperative_groups;

#ifndef ONE_LAUNCH
#define ONE_LAUNCH 1
#endif

#define LAS __attribute__((address_space(3)))
typedef unsigned short bf16_t;
typedef short bf16x8 __attribute__((ext_vector_type(8)));
typedef float f32x4 __attribute__((ext_vector_type(4)));
typedef float f32x2 __attribute__((ext_vector_type(2)));
typedef unsigned u32x4 __attribute__((ext_vector_type(4)));
typedef unsigned u32x2 __attribute__((ext_vector_type(2)));

constexpr int D = 1024, NB = 32, SEQ = 2048, CTXL = 256, NLAT = NB * SEQ, NCTX = NB * CTXL, MTOT = NLAT + NCTX;
constexpr int DIN = 1280, DFF = 2816, TCH = 32  , NBC = MTOT / TCH  , KY = 768, KS = 512;
constexpr int NPH = 22;
constexpr int LDS_BYTES = 147456;
constexpr float EPS = 1e-6f;

constexpr size_t al256(size_t x) { return (x + 255) & ~(size_t)255; }
constexpr size_t WS_WINT = 0;
constexpr size_t WS_WOUTT = WS_WINT + al256((size_t)2 * DIN * D * 2);
constexpr size_t WS_GLUT = WS_WOUTT + al256((size_t)2 * D * D * 2);
constexpr size_t WS_WGUT = WS_GLUT + al256((size_t)2 * 512 * 512 * 2);
constexpr size_t WS_WDT = WS_WGUT + al256((size_t)2 * 2 * DFF * D * 2);
constexpr size_t WS_SGUW = WS_WDT + al256((size_t)2 * D * DFF * 2);
constexpr size_t WS_POOLWT = WS_SGUW + al256((size_t)2 * 4 * 128 * 128 * 2);
constexpr size_t WS_MOD = WS_POOLWT + al256((size_t)2 * 4 * 64 * 64 * 2);
constexpr size_t WS_PE = WS_MOD + al256((size_t)2 * 33 * 6144 * 4);
constexpr size_t WS_KT = WS_PE + al256((size_t)96 * 512 * 4);
constexpr size_t WS_LAMP = WS_KT + al256((size_t)2 * 32 * 2 * 32 * 256 * 4);
constexpr size_t WS_BBAR = WS_LAMP + al256((size_t)2 * 32 * 2 * 64 * 33 * 8);
constexpr size_t WS_SMAT = WS_BBAR + al256((size_t)2 * 32 * 2 * 64 * 16 * 8);
constexpr size_t WS_YMAT = WS_SMAT + al256((size_t)2 * 32 * 256 * 512 * 2);
constexpr size_t WS_XCTX = WS_YMAT + al256((size_t)2 * 32 * 512 * 768 * 2);
constexpr size_t WS_H = WS_XCTX + al256((size_t)NCTX * D * 4);
constexpr size_t WS_R = WS_H + al256((size_t)MTOT * D * 2);
constexpr size_t WS_Z = WS_R;
constexpr size_t WS_CAT = WS_Z + al256((size_t)MTOT * DIN * 2);
constexpr size_t WS_MOUT = WS_CAT + al256((size_t)MTOT * D * 2);
constexpr size_t WS_REND = WS_MOUT + al256((size_t)MTOT * D * 2);
constexpr size_t WS_HID = WS_R;
constexpr size_t WS_S = WS_MOUT;
constexpr size_t WS_USSM = WS_REND;
constexpr size_t WS_F = WS_USSM;
constexpr size_t WS_END = WS_USSM + al256((size_t)MTOT * D * 2);
static_assert((size_t)MTOT * DFF * 2 <= WS_REND - WS_R, "HID alias");
static_assert((size_t)32 * NBC * 256 * 4 <= (size_t)MTOT * D * 2, "S alias");
static_assert((size_t)32 * NBC * KY * 2 <= (size_t)MTOT * D * 2, "USSM alias");

struct Params {
    const float* in[29];
    float* out;
    unsigned char* ws;
    int ph_lo, ph_hi, sync, pad;
};

__device__ __forceinline__ unsigned cvt_pk_bf16(float lo, float hi) { unsigned r; asm volatile("v_cvt_pk_bf16_f32 %0, %1, %2" : "=v"(r) : "v"(lo), "v"(hi)); return r; }
__device__ __forceinline__ float bf_lo(unsigned w) { return __uint_as_float(w << 16); }
__device__ __forceinline__ float bf_hi(unsigned w) { return __uint_as_float(w & 0xffff0000u); }
__device__ __forceinline__ float gelu_t(float x) { const float u = 1.5957691216057308f * (x + 0.044715f * x * x * x); return __fdividef(x, 1.0f + __expf(-u)); }
__device__ __forceinline__ float silu_f(float x) { return __fdividef(x, 1.0f + __expf(-x)); }
__device__ __forceinline__ float sigmoid_f(float x) { return __fdividef(1.0f, 1.0f + __expf(-x)); }
__device__ __forceinline__ int tid_l() { int t = threadIdx.x; asm volatile("" : "+v"(t)); return t; }
__device__ __forceinline__ float wave_sum(float v) {
#pragma unroll
    for (int o = 1; o < 64; o <<= 1) v += __shfl_xor(v, o);
    return v;
}

constexpr int BM = 256, BK = 64, HALF = 128, HTB = HALF * BK * 2, NXCD = 8, WGM = 8;
__host__ __device__ __forceinline__ int lds_byte(int r, int c) { const int st = (r >> 4) * 2 + (c >> 5), rr = r & 15, cc = c & 31, ob = rr * 64 + cc * 2; return st * 1024 + (ob ^ (((ob >> 9) & 1) << 5)); }
__host__ __device__ __forceinline__ void stage_rc(int b, int& R, int& C) { const int st = b / 1024, sb = b % 1024, swz = sb ^ (((sb >> 9) & 1) << 5); R = (st >> 1) * 16 + swz / 64; C = (st & 1) * 32 + (swz % 64) / 2; }
__host__ __device__ __forceinline__ int perm32(int rho) { const int n = rho >> 4, i = rho & 15; return 8 * (i >> 2) + 4 * n + (i & 3); }

struct Unit { int pm, pn, g; };
struct GemmP { const bf16_t* A; const bf16_t* Bt; int lda, ldb, K; size_t gsA, gsB; };

struct Sched {
    int nM, nN, n1, nM2, nN2, pm2, pn2, total, G, c;
    __device__ void init(int nM_, int nN_, int nG_, int nM2_, int nN2_, int pm2_, int pn2_) {
        nM = nM_; nN = nN_; n1 = nM_ * nN_ * nG_; nM2 = nM2_; nN2 = nN2_; pm2 = pm2_; pn2 = pn2_; total = n1 + nM2_ * nN2_; G = (int)gridDim.x; c = (int)blockIdx.x;
    }
    __device__ __forceinline__ static void dec(int w, int nM_, int nN_, int& pm, int& pn) {
        const int nig = WGM * nN_, gid = w / nig, fm = gid * WGM, gsz = (nM_ - fm) < WGM ? (nM_ - fm) : WGM;
        pm = fm + ((w % nig) % gsz); pn = (w % nig) / gsz;
    }
    __device__ bool next(int i, Unit& u) const {
        const long L = (long)i * G + c; if (L >= total) return false;
        int w = (int)L; { const int q = total / NXCD, r = total % NXCD, xcd = w % NXCD, off = w / NXCD; w = (xcd < r ? xcd * (q + 1) : r * (q + 1) + (xcd - r) * q) + off; }
        if (w < n1) { const int per = nM * nN; u.g = w / per; dec(w % per, nM, nN, u.pm, u.pn); }
        else { u.g = 0; dec(w - n1, nM2, nN2, u.pm, u.pn); u.pm += pm2; u.pn += pn2; }
        return true;
    }
};

template <class Epi>
__device__ __forceinline__ void gemm_phase(LAS unsigned char* lds, const GemmP g, const Sched& S, const Epi& E) {
    const int tid = tid_l(), wid = __builtin_amdgcn_readfirstlane(tid >> 6), lane = tid & 63, wr = wid >> 2, wc = wid & 3, fr = lane & 15, fq = lane >> 4;
    const int nt = g.K / BK;
    unsigned voffA[2], voffB[2];
#pragma unroll
    for (int i = 0; i < 2; ++i) { int R, C; stage_rc(tid * 16 + i * 8192, R, C); const int Rb = (R & ~31) + perm32(R & 31);
        voffA[i] = (unsigned)(R * g.lda + C) * 2u; voffB[i] = (unsigned)(Rb * g.ldb + C) * 2u; }
    const size_t kstep = (size_t)(BK * 2);
    const size_t hstepA = (size_t)HALF * g.lda * 2, hstepB = (size_t)HALF * g.ldb * 2;
    const size_t tstepA = 2 * hstepA, tstepB = 2 * hstepB;
    const unsigned ldsw = (unsigned)wid * 1024u;
    const int aoff = lds_byte(wr * 64 + fr, fq * 8), boff = lds_byte(wc * 32 + fr, fq * 8);
#define PG8_SA(b, h) (((b) * 2 + (h)) * HTB)
#define PG8_SB(b, h) ((4 + (b) * 2 + (h)) * HTB)
#define PG8_STAGE(bufoff, gbase, voff) do { _Pragma("unroll") for (int _i = 0; _i < 2; ++_i) \
        __builtin_amdgcn_global_load_lds((const unsigned*)((const char*)(gbase) + (voff)[_i]), (LAS unsigned*)(lds + (bufoff) + ldsw + _i * 8192), 16, 0, 0); } while (0)
#define PG8_LDA(dst, b, h) do { _Pragma("unroll") for (int m = 0; m < 4; ++m) _Pragma("unroll") for (int k = 0; k < 2; ++k) dst[m][k] = *(const LAS bf16x8*)(lds + PG8_SA(b, h) + aoff + m * 2048 + k * 1024); } while (0)
#define PG8_LDB(dst, b, h) do { _Pragma("unroll") for (int n = 0; n < 2; ++n) _Pragma("unroll") for (int k = 0; k < 2; ++k) dst[n][k] = *(const LAS bf16x8*)(lds + PG8_SB(b, h) + boff + n * 2048 + k * 1024); } while (0)
#define PG8_MMA(ai, bj, At, Bt) do { __builtin_amdgcn_s_setprio(1); _Pragma("unroll") for (int m = 0; m < 4; ++m) _Pragma("unroll") for (int n = 0; n < 2; ++n) _Pragma("unroll") for (int k = 0; k < 2; ++k) \
        acc[ai][bj][m][n] = __builtin_amdgcn_mfma_f32_16x16x32_bf16(Bt[n][k], At[m][k], acc[ai][bj][m][n], 0, 0, 0); __builtin_amdgcn_s_setprio(0); } while (0)
#define PG8_WAIT_V(n) asm volatile("s_waitcnt vmcnt(" #n ")" ::: "memory")
#define PG8_WAIT_L(n) asm volatile("s_waitcnt lgkmcnt(" #n ")" ::: "memory")
#define PG8_BAR __builtin_amdgcn_s_barrier()
#define PG8_SCHED __builtin_amdgcn_sched_barrier(0)
    Unit cur, nxt; int ui = 0;
    if (!S.next(0, cur)) return;
    f32x4 acc[2][2][4][2];
#pragma unroll
    for (int a = 0; a < 2; ++a)
#pragma unroll
        for (int b = 0; b < 2; ++b)
#pragma unroll
            for (int m = 0; m < 4; ++m)
#pragma unroll
                for (int n = 0; n < 2; ++n) acc[a][b][m][n] = (f32x4){0.f, 0.f, 0.f, 0.f};
    bf16x8 At[4][2], B0[2][2], B1[2][2];
    const char* cA = (const char*)g.A + (size_t)cur.g * g.gsA * 2 + (size_t)cur.pm * tstepA;
    const char* cB = (const char*)g.Bt + (size_t)cur.g * g.gsB * 2 + (size_t)cur.pn * tstepB;
    PG8_STAGE(PG8_SB(0, 0), cB, voffB); PG8_STAGE(PG8_SA(0, 0), cA, voffA); PG8_STAGE(PG8_SB(0, 1), cB + hstepB, voffB); PG8_STAGE(PG8_SA(0, 1), cA + hstepA, voffA);
    if (wr == 1) PG8_BAR;
    PG8_WAIT_V(4); PG8_BAR;
    PG8_STAGE(PG8_SB(1, 0), cB + kstep, voffB); PG8_STAGE(PG8_SA(1, 0), cA + kstep, voffA); PG8_STAGE(PG8_SB(1, 1), cB + hstepB + kstep, voffB);
    PG8_WAIT_V(6); PG8_BAR;
    for (;;) {
        const bool has_next = S.next(ui + 1, nxt);
        const char* nA = has_next ? (const char*)g.A + (size_t)nxt.g * g.gsA * 2 + (size_t)nxt.pm * tstepA : cA;
        const char* nB = has_next ? (const char*)g.Bt + (size_t)nxt.g * g.gsB * 2 + (size_t)nxt.pn * tstepB : cB;
        for (int t = 0; t < nt; t += 2) {
            const bool last = (t == nt - 2);
            const char* a1 = cA + (size_t)(t + 1) * kstep;
            const char* a2 = last ? nA : cA + (size_t)(t + 2) * kstep; const char* b2 = last ? nB : cB + (size_t)(t + 2) * kstep;
            const char* a3 = a2 + kstep; const char* b3 = b2 + kstep;
            PG8_LDB(B0, 0, 0); PG8_SCHED; PG8_LDA(At, 0, 0); PG8_STAGE(PG8_SA(1, 1), a1 + hstepA, voffA);
            PG8_WAIT_L(8); PG8_BAR; PG8_WAIT_L(0); PG8_MMA(0, 0, At, B0); PG8_BAR; PG8_SCHED;
            PG8_LDB(B1, 0, 1); PG8_STAGE(PG8_SB(0, 0), b2, voffB);
            PG8_BAR; PG8_WAIT_L(0); PG8_MMA(0, 1, At, B1); PG8_BAR;
            PG8_LDA(At, 0, 1); PG8_STAGE(PG8_SA(0, 0), a2, voffA);
            PG8_BAR; PG8_WAIT_L(0); PG8_MMA(1, 0, At, B0); PG8_BAR; PG8_SCHED;
            PG8_STAGE(PG8_SB(0, 1), b2 + hstepB, voffB);
            PG8_WAIT_V(6); PG8_BAR; PG8_MMA(1, 1, At, B1); PG8_BAR;
            PG8_LDB(B0, 1, 0); PG8_SCHED; PG8_LDA(At, 1, 0); PG8_STAGE(PG8_SA(0, 1), a2 + hstepA, voffA);
            PG8_WAIT_L(8); PG8_BAR; PG8_WAIT_L(0); PG8_MMA(0, 0, At, B0); PG8_BAR; PG8_SCHED;
            PG8_LDB(B1, 1, 1); PG8_STAGE(PG8_SB(1, 0), b3, voffB);
            PG8_BAR; PG8_WAIT_L(0); PG8_MMA(0, 1, At, B1); PG8_BAR;
            PG8_LDA(At, 1, 1); PG8_STAGE(PG8_SA(1, 0), a3, voffA);
            PG8_BAR; PG8_WAIT_L(0); PG8_MMA(1, 0, At, B0); PG8_BAR; PG8_SCHED;
            PG8_STAGE(PG8_SB(1, 1), b3 + hstepB, voffB);
            PG8_WAIT_V(6); PG8_BAR; PG8_MMA(1, 1, At, B1); PG8_BAR;
        }
        E(acc, cur, wr, wc, fr, fq);
        if (!has_next) break;
#pragma unroll
        for (int a = 0; a < 2; ++a)
#pragma unroll
            for (int b = 0; b < 2; ++b)
#pragma unroll
                for (int m = 0; m < 4; ++m)
#pragma unroll
                    for (int n = 0; n < 2; ++n) acc[a][b][m][n] = (f32x4){0.f, 0.f, 0.f, 0.f};
        cur = nxt; cA = nA; cB = nB; ++ui;
    }
    PG8_WAIT_V(0);
    if (wr == 0) PG8_BAR;
    PG8_BAR;
#undef PG8_SA
#undef PG8_SB
#undef PG8_STAGE
#undef PG8_LDA
#undef PG8_LDB
#undef PG8_MMA
#undef PG8_WAIT_V
#undef PG8_WAIT_L
#undef PG8_BAR
#undef PG8_SCHED
}

__device__ __forceinline__ u32x4 pack8(const f32x4 a, const f32x4 b) { u32x4 w; w.x = cvt_pk_bf16(a[0], a[1]); w.y = cvt_pk_bf16(a[2], a[3]); w.z = cvt_pk_bf16(b[0], b[1]); w.w = cvt_pk_bf16(b[2], b[3]); return w; }

struct EpiWin {
    bf16_t* Z; bf16_t* U;
    __device__ __forceinline__ void operator()(const f32x4 (&acc)[2][2][4][2], const Unit& u, int wr, int wc, int fr, int fq) const {
        const int row0 = u.pm * BM + wr * 64 + fr;
#pragma unroll
        for (int ai = 0; ai < 2; ++ai)
#pragma unroll
            for (int m = 0; m < 4; ++m) {
                const int r = row0 + ai * HALF + m * 16;
#pragma unroll
                for (int bj = 0; bj < 2; ++bj) {
                    const int c0 = u.pn * BM + bj * HALF + wc * 32 + 8 * fq;
                    f32x4 v0 = acc[ai][bj][m][0], v1 = acc[ai][bj][m][1];
                    if (u.pn < 2) {
#pragma unroll
                        for (int j = 0; j < 4; ++j) { v0[j] = gelu_t(v0[j]); v1[j] = gelu_t(v1[j]); }
                        *(u32x4*)(Z + (size_t)r * DIN + c0) = pack8(v0, v1);
                    } else if (u.pn < 4) {
                        const int cc = c0 - 512, gg = cc >> 4, h0 = cc & 15;
                        *(u32x4*)(U + ((size_t)gg * NBC + (r >> 5)) * KY + (r & 31) * 16 + h0) = pack8(v0, v1);
                    } else {
                        *(u32x4*)(Z + (size_t)r * DIN + c0) = pack8(v0, v1);
                    }
                }
            }
    }
};
struct EpiS {
    float* S;
    __device__ __forceinline__ void operator()(const f32x4 (&acc)[2][2][4][2], const Unit& u, int wr, int wc, int fr, int fq) const {
        const int row0 = u.pm * BM + wr * 64 + fr;
#pragma unroll
        for (int ai = 0; ai < 2; ++ai)
#pragma unroll
            for (int m = 0; m < 4; ++m) {
                const int r = row0 + ai * HALF + m * 16;
                float* rp = S + ((size_t)u.g * NBC + r) * 256 + wc * 32 + 8 * fq;
#pragma unroll
                for (int bj = 0; bj < 2; ++bj) { *(f32x4*)(rp + bj * HALF) = acc[ai][bj][m][0]; *(f32x4*)(rp + bj * HALF + 4) = acc[ai][bj][m][1]; }
            }
    }
};
struct EpiY {
    bf16_t* Z;
    __device__ __forceinline__ void operator()(const f32x4 (&acc)[2][2][4][2], const Unit& u, int wr, int wc, int fr, int fq) const {
        const int row0 = u.pm * BM + wr * 64 + fr;
#pragma unroll
        for (int ai = 0; ai < 2; ++ai)
#pragma unroll
            for (int m = 0; m < 4; ++m) {
                const int bc = row0 + ai * HALF + m * 16;
#pragma unroll
                for (int bj = 0; bj < 2; ++bj) {
                    const int c0 = u.pn * BM + bj * HALF + wc * 32 + 8 * fq, j = c0 >> 4, h0 = c0 & 15;
                    f32x4 v0 = acc[ai][bj][m][0], v1 = acc[ai][bj][m][1];
#pragma unroll
                    for (int q = 0; q < 4; ++q) { v0[q] = gelu_t(v0[q]); v1[q] = gelu_t(v1[q]); }
                    *(u32x4*)(Z + ((size_t)bc * TCH + j) * DIN + 512 + u.g * 16 + h0) = pack8(v0, v1);
                }
            }
    }
};
struct EpiGlu {
    const bf16_t* Z; bf16_t* CAT; const float* bias;
    __device__ __forceinline__ void operator()(const f32x4 (&acc)[2][2][4][2], const Unit& u, int wr, int wc, int fr, int fq) const {
        const int row0 = u.pm * BM + wr * 64 + fr;
#pragma unroll
        for (int bj = 0; bj < 2; ++bj) {
            const int c0 = u.pn * BM + bj * HALF + wc * 32 + 8 * fq;
            const f32x4 b0 = *(const f32x4*)(bias + c0), b1 = *(const f32x4*)(bias + c0 + 4);
#pragma unroll
            for (int ai = 0; ai < 2; ++ai)
#pragma unroll
                for (int m = 0; m < 4; ++m) {
                    const int r = row0 + ai * HALF + m * 16;
                    const u32x4 gw = *(const u32x4*)(Z + (size_t)r * DIN + 512 + c0);
                    f32x4 v0 = acc[ai][bj][m][0] + b0, v1 = acc[ai][bj][m][1] + b1;
                    v0[0] = bf_lo(gw.x) * sigmoid_f(v0[0]); v0[1] = bf_hi(gw.x) * sigmoid_f(v0[1]); v0[2] = bf_lo(gw.y) * sigmoid_f(v0[2]); v0[3] = bf_hi(gw.y) * sigmoid_f(v0[3]);
                    v1[0] = bf_lo(gw.z) * sigmoid_f(v1[0]); v1[1] = bf_hi(gw.z) * sigmoid_f(v1[1]); v1[2] = bf_lo(gw.w) * sigmoid_f(v1[2]); v1[3] = bf_hi(gw.w) * sigmoid_f(v1[3]);
                    *(u32x4*)(CAT + (size_t)r * D + 256 + c0) = pack8(v0, v1);
                }
        }
    }
};
struct EpiBf {
    bf16_t* O; int ldc;
    __device__ __forceinline__ void operator()(const f32x4 (&acc)[2][2][4][2], const Unit& u, int wr, int wc, int fr, int fq) const {
        const int row0 = u.pm * BM + wr * 64 + fr, col0 = u.pn * BM + wc * 32 + 8 * fq;
#pragma unroll
        for (int ai = 0; ai < 2; ++ai)
#pragma unroll
            for (int m = 0; m < 4; ++m) {
                bf16_t* rp = O + (size_t)(row0 + ai * HALF + m * 16) * ldc + col0;
#pragma unroll
                for (int bj = 0; bj < 2; ++bj) *(u32x4*)(rp + bj * HALF) = pack8(acc[ai][bj][m][0], acc[ai][bj][m][1]);
            }
    }
};
struct EpiGU {
    bf16_t* HID;
    __device__ __forceinline__ void operator()(const f32x4 (&acc)[2][2][4][2], const Unit& u, int wr, int wc, int fr, int fq) const {
        const int row0 = u.pm * BM + wr * 64 + fr, col0 = u.pn * HALF + wc * 32 + 8 * fq;
#pragma unroll
        for (int ai = 0; ai < 2; ++ai)
#pragma unroll
            for (int m = 0; m < 4; ++m) {
                f32x4 v0, v1;
#pragma unroll
                for (int j = 0; j < 4; ++j) { v0[j] = silu_f(acc[ai][0][m][0][j]) * acc[ai][1][m][0][j]; v1[j] = silu_f(acc[ai][0][m][1][j]) * acc[ai][1][m][1][j]; }
                *(u32x4*)(HID + (size_t)(row0 + ai * HALF + m * 16) * DFF + col0) = pack8(v0, v1);
            }
    }
};

__device__ __forceinline__ void transpose_tile(const float* W, int K, int N, bf16_t* WT, int mode, int tile, LAS float* scr) {
    const int t = tid_l(), nblk = N / 64, kb = tile / nblk, nb = tile % nblk, k0 = kb * 64, n0 = nb * 64;
#pragma unroll
    for (int i = 0; i < 8; ++i) { const int idx = t + 512 * i, k = idx >> 6, n = idx & 63; scr[k * 65 + n] = W[(size_t)(k0 + k) * N + n0 + n]; }
    __syncthreads();
#pragma unroll
    for (int i = 0; i < 4; ++i) { const int idx = t + 512 * i, n = idx >> 5, kp = idx & 31;
        const int ncol = n0 + n; int drow = ncol;
        if (mode == 1) drow = 256 * (ncol >> 7) + (ncol & 127); else if (mode == 2) drow = 256 * (ncol >> 7) + 128 + (ncol & 127);
        *(unsigned*)(WT + (size_t)drow * K + k0 + 2 * kp) = cvt_pk_bf16(scr[(2 * kp) * 65 + n], scr[(2 * kp + 1) * 65 + n]); }
    __syncthreads();
}

__device__ void p0_mod_slab(const Params& p, int sl, LAS float* lds) {
    const int t = tid_l(), l = sl / 96, n0 = (sl % 96) * 64, col = t & 63, ks = t >> 6;
    const float* W = p.in[4] + (size_t)l * D * 6144; const float* bm = p.in[5] + (size_t)l * 6144;
    LAS float* sv = lds;
    LAS float* red = lds + 33 * 512;
    float acc[33];
#pragma unroll
    for (int b = 0; b < 33; ++b) acc[b] = 0.f;
    for (int half = 0; half < 2; ++half) {
        __syncthreads();
        for (int i = t; i < 33 * 512; i += 512) { const int b = i >> 9, k = (i & 511) + half * 512; const float cv = b < 32 ? p.in[1][b * D + k] : p.in[3][k]; sv[i] = silu_f(cv); }
        __syncthreads();
        for (int kk = 0; kk < 64; kk += 4) {
            const int kl = ks * 64 + kk, kg = half * 512 + kl;
            const float w0 = W[(size_t)(kg + 0) * 6144 + n0 + col], w1 = W[(size_t)(kg + 1) * 6144 + n0 + col], w2 = W[(size_t)(kg + 2) * 6144 + n0 + col], w3 = W[(size_t)(kg + 3) * 6144 + n0 + col];
#pragma unroll
            for (int b = 0; b < 33; ++b) { const f32x4 s = *(const LAS f32x4*)(sv + b * 512 + kl); acc[b] += s[0] * w0 + s[1] * w1 + s[2] * w2 + s[3] * w3; }
        }
    }
#pragma unroll
    for (int b = 0; b < 33; ++b) red[(ks * 33 + b) * 64 + col] = acc[b];
    __syncthreads();
    float* MOD = (float*)(p.ws + WS_MOD) + (size_t)l * 33 * 6144;
    for (int i = t; i < 33 * 64; i += 512) { const int b = i >> 6, cc = i & 63; float s = bm[n0 + cc];
#pragma unroll
        for (int k8 = 0; k8 < 8; ++k8) s += red[(k8 * 33 + b) * 64 + cc];
        MOD[(size_t)b * 6144 + n0 + cc] = s; }
    __syncthreads();
}

__device__ void p0_ssm_tables(const Params& p, int lg, LAS float* lds) {
    const int t = tid_l(), l = lg >> 5, g = lg & 31;
    LAS f32x2* lamp = (LAS f32x2*)lds;
    LAS f32x2* bbar = lamp + 2 * 64 * 33;
    LAS f32x2* cc = bbar + 2 * 64 * 16;
    f32x2* gl = (f32x2*)(p.ws + WS_LAMP) + (size_t)lg * 2 * 64 * 33;
    f32x2* gb = (f32x2*)(p.ws + WS_BBAR) + (size_t)lg * 2 * 64 * 16;
    __syncthreads();
    for (int i = t; i < 2 * 64 * 33; i += 512) {
        const int dir = i / (64 * 33), pp = (i / 33) % 64, n = i % 33;
        const size_t li = ((size_t)(l * 2 + dir) * 32 + g) * 64 + pp;
        const float dt = expf(p.in[16][(l * 2 + dir) * 32 + g]);
        const float a = p.in[14][li] * dt, b = p.in[15][li] * dt;
        const float mag = expf(a * (float)n); float sn, cs; sincosf(b * (float)n, &sn, &cs);
        const f32x2 v = {mag * cs, mag * sn}; lamp[i] = v; gl[i] = v;
    }
    for (int i = t; i < 2 * 64 * 16; i += 512) {
        const int dir = i / (64 * 16), pp = (i / 16) % 64, h = i % 16;
        const size_t li = ((size_t)(l * 2 + dir) * 32 + g) * 64 + pp;
        const float dt = expf(p.in[16][(l * 2 + dir) * 32 + g]);
        const float lr = p.in[14][li], lim = p.in[15][li];
        const float a = lr * dt, b = lim * dt;
        float sn, cs; sincosf(b, &sn, &cs); const float sh = sinf(0.5f * b);
        const float xr = expm1f(a) * cs - 2.0f * sh * sh, xi = expf(a) * sn;
        const float den = 1.0f / (lr * lr + lim * lim);
        const float qr = (xr * lr + xi * lim) * den, qi = (xi * lr - xr * lim) * den;
        const float br = p.in[17][li * 16 + h], bi = p.in[18][li * 16 + h];
        const f32x2 v = {qr * br - qi * bi, qr * bi + qi * br}; bbar[i] = v; gb[i] = v;
    }
    for (int i = t; i < 2 * 16 * 64; i += 512) {
        const int dir = i / 1024, h = (i / 64) % 16, pp = i % 64;
        const size_t ci = (((size_t)(l * 2 + dir) * 32 + g) * 16 + h) * 64 + pp;
        cc[i] = (f32x2){p.in[19][ci], p.in[20][ci]};
    }
    __syncthreads();
    float* KT = (float*)(p.ws + WS_KT) + (size_t)lg * 2 * 32 * 256;
    for (int e = t; e < 2 * 32 * 256; e += 512) {
        const int dir = e >> 13, n = (e >> 8) & 31, h = (e >> 4) & 15, hp = e & 15;
        float s = 0.f;
        for (int pp = 0; pp < 64; ++pp) {
            const f32x2 c = cc[(dir * 16 + h) * 64 + pp], lm = lamp[(dir * 64 + pp) * 33 + n], bb = bbar[(dir * 64 + pp) * 16 + hp];
            const float tr = c.x * lm.x - c.y * lm.y, ti = c.x * lm.y + c.y * lm.x;
            s += tr * bb.x - ti * bb.y;
        }
        KT[e] = s;
    }
    __syncthreads();
}

__device__ void phase_p0(const Params& p, LAS unsigned char* lds) {
    const int t = tid_l(), w = blockIdx.x, G = gridDim.x;
    if (w < 64) p0_ssm_tables(p, w, (LAS float*)lds);
    for (int sl = (w >= 64 ? w - 64 : w + G - 64); sl < 192; sl += G) p0_mod_slab(p, sl, (LAS float*)lds);
    {
        constexpr int T_IN = 16 * 20, T_OUT = 16 * 16, T_GLU = 8 * 8, T_G = 16 * 44, T_D = 44 * 16, T_L = T_IN + T_OUT + T_GLU + 2 * T_G + T_D;
        LAS float* scr = (LAS float*)lds;
        for (int it = w; it < 2 * T_L; it += G) {
            const int l = it / T_L; int r = it % T_L;
            if (r < T_IN) { transpose_tile(p.in[10] + (size_t)l * D * DIN, D, DIN, (bf16_t*)(p.ws + WS_WINT) + (size_t)l * DIN * D, 0, r, scr); continue; } r -= T_IN;
            if (r < T_OUT) { transpose_tile(p.in[11] + (size_t)l * D * D, D, D, (bf16_t*)(p.ws + WS_WOUTT) + (size_t)l * D * D, 0, r, scr); continue; } r -= T_OUT;
            if (r < T_GLU) { transpose_tile(p.in[22] + (size_t)l * 512 * 512, 512, 512, (bf16_t*)(p.ws + WS_GLUT) + (size_t)l * 512 * 512, 0, r, scr); continue; } r -= T_GLU;
            if (r < T_G) { transpose_tile(p.in[26] + (size_t)l * D * DFF, D, DFF, (bf16_t*)(p.ws + WS_WGUT) + (size_t)l * 2 * DFF * D, 1, r, scr); continue; } r -= T_G;
            if (r < T_G) { transpose_tile(p.in[27] + (size_t)l * D * DFF, D, DFF, (bf16_t*)(p.ws + WS_WGUT) + (size_t)l * 2 * DFF * D, 2, r, scr); continue; } r -= T_G;
            transpose_tile(p.in[28] + (size_t)l * DFF * D, DFF, D, (bf16_t*)(p.ws + WS_WDT) + (size_t)l * D * DFF, 0, r, scr);
        }
    }
    const int gt = w * 512 + t, GT = G * 512;
    { float* pe = (float*)(p.ws + WS_PE);
      for (int i = gt; i < 96 * 512; i += GT) { const int pos = i >> 9, cidx = i & 511, k = cidx & 255; const int ps = pos < 32 ? pos : pos - 32;
          const float om = expf(-9.210340371976184f * (float)k * (1.0f / 256.0f)); const float ang = (float)ps * om; pe[i] = cidx < 256 ? sinf(ang) : cosf(ang); } }
    { bf16_t* sw = (bf16_t*)(p.ws + WS_SGUW); for (int i = gt; i < 2 * 4 * 128 * 128 / 2; i += GT) *(unsigned*)(sw + 2 * i) = cvt_pk_bf16(p.in[12][2 * i], p.in[12][2 * i + 1]);
      bf16_t* pw = (bf16_t*)(p.ws + WS_POOLWT); for (int i = gt; i < 2 * 4 * 64 * 64; i += GT) { const int li = i >> 12, o = (i >> 6) & 63, ch = i & 63; pw[i] = (bf16_t)(cvt_pk_bf16(p.in[24][(size_t)li * 4096 + ch * 64 + o], 0.f) & 0xffffu); } }
}

__device__ __forceinline__ void row_pass(const float* xin, const float* per, const float* pec, const bf16_t* src, const float* wpost, const float* gate,
                                         float* xout, const float* wpre, const float* sh, const float* sc, bf16_t* hout, int lane) {
    f32x4 x[4];
#pragma unroll
    for (int j = 0; j < 4; ++j) x[j] = *(const f32x4*)(xin + 4 * lane + 256 * j);
    if (per) {
#pragma unroll
        for (int j = 0; j < 2; ++j) { x[j] += *(const f32x4*)(per + 4 * lane + 256 * j); x[j + 2] += *(const f32x4*)(pec + 4 * lane + 256 * j); }
    }
    if (src) {
        f32x4 s[4]; float ss = 0.f;
#pragma unroll
        for (int j = 0; j < 4; ++j) { const u32x2 w = *(const u32x2*)(src + 4 * lane + 256 * j); s[j] = (f32x4){bf_lo(w.x), bf_hi(w.x), bf_lo(w.y), bf_hi(w.y)}; ss += (s[j][0] * s[j][0] + s[j][1] * s[j][1]) + (s[j][2] * s[j][2] + s[j][3] * s[j][3]); }
        const float rstd = rsqrtf(wave_sum(ss) * (1.0f / D) + EPS);
#pragma unroll
        for (int j = 0; j < 4; ++j) { const f32x4 wv = *(const f32x4*)(wpost + 4 * lane + 256 * j), gv = *(const f32x4*)(gate + 4 * lane + 256 * j); x[j] += gv * (s[j] * rstd * wv); }
    }
    if (xout) {
#pragma unroll
        for (int j = 0; j < 4; ++j) *(f32x4*)(xout + 4 * lane + 256 * j) = x[j];
    }
    if (hout) {
        float ss = 0.f;
#pragma unroll
        for (int j = 0; j < 4; ++j) ss += (x[j][0] * x[j][0] + x[j][1] * x[j][1]) + (x[j][2] * x[j][2] + x[j][3] * x[j][3]);
        const float rstd = rsqrtf(wave_sum(ss) * (1.0f / D) + EPS);
#pragma unroll
        for (int j = 0; j < 4; ++j) { const f32x4 wv = *(const f32x4*)(wpre + 4 * lane + 256 * j), sv = *(const f32x4*)(sh + 4 * lane + 256 * j), cv = *(const f32x4*)(sc + 4 * lane + 256 * j);
            const f32x4 h = (x[j] * rstd * wv) * (1.0f + cv) + sv;
            *(u32x2*)(hout + 4 * lane + 256 * j) = (u32x2){cvt_pk_bf16(h[0], h[1]), cvt_pk_bf16(h[2], h[3])}; }
    }
}

__device__ void phase_p1(const Params& p) {
    const int t = tid_l(), w = blockIdx.x, G = gridDim.x, lane = t & 63;
    const size_t gt = (size_t)w * 512 + t, GT = (size_t)G * 512;
    { bf16_t* SM = (bf16_t*)(p.ws + WS_SMAT); const f32x2* gl = (const f32x2*)(p.ws + WS_LAMP); const f32x2* gb = (const f32x2*)(p.ws + WS_BBAR);
      for (size_t it = gt; it < (size_t)2 * 32 * 256 * 64; it += GT) {
          const int k8 = (int)(it & 63), n = (int)((it >> 6) & 255), lg = (int)(it >> 14);
          const int dir = n >> 7, pp = (n >> 1) & 63, ri = n & 1, s = k8 >> 1, h0 = (k8 & 1) * 8, e = dir == 0 ? 31 - s : s;
          const f32x2 lm = gl[((size_t)(lg * 2 + dir) * 64 + pp) * 33 + e]; const f32x2* bb = gb + ((size_t)(lg * 2 + dir) * 64 + pp) * 16 + h0;
          float v[8];
#pragma unroll
          for (int j = 0; j < 8; ++j) { const f32x2 b = bb[j]; v[j] = ri ? (lm.x * b.y + lm.y * b.x) : (lm.x * b.x - lm.y * b.y); }
          u32x4 o; o.x = cvt_pk_bf16(v[0], v[1]); o.y = cvt_pk_bf16(v[2], v[3]); o.z = cvt_pk_bf16(v[4], v[5]); o.w = cvt_pk_bf16(v[6], v[7]);
          *(u32x4*)(SM + it * 8) = o; } }
    { bf16_t* YM = (bf16_t*)(p.ws + WS_YMAT); const float* KT = (const float*)(p.ws + WS_KT); const f32x2* gl = (const f32x2*)(p.ws + WS_LAMP);
      for (size_t it = gt; it < (size_t)2 * 32 * 512 * 96; it += GT) {
          const int k8 = (int)(it % 96); const size_t rr = it / 96; const int row = (int)(rr & 511), lg = (int)(rr >> 9), l = lg >> 5, g = lg & 31, j = row >> 4, h = row & 15;
          float v[8];
          if (k8 < 64) {
              const int s = k8 >> 1, h0 = (k8 & 1) * 8, n = j - s;
              if (n > 0) { const float* kp = KT + (((size_t)lg * 2 + 0) * 32 + n) * 256 + h * 16 + h0;
#pragma unroll
                  for (int q = 0; q < 8; ++q) v[q] = kp[q]; }
              else if (n < 0) { const float* kp = KT + (((size_t)lg * 2 + 1) * 32 + (-n)) * 256 + h * 16 + h0;
#pragma unroll
                  for (int q = 0; q < 8; ++q) v[q] = kp[q]; }
              else { const float* k0 = KT + (((size_t)lg * 2 + 0) * 32) * 256 + h * 16 + h0; const float* k1 = KT + (((size_t)lg * 2 + 1) * 32) * 256 + h * 16 + h0; const float dd = p.in[21][(l * 32 + g) * 16 + h];
#pragma unroll
                  for (int q = 0; q < 8; ++q) v[q] = k0[q] + k1[q] + ((h0 + q) == h ? dd : 0.f); }
          } else {
              const int kk = (k8 - 64) * 8, dir = kk >> 7, p0 = (kk & 127) >> 1, e = dir == 0 ? j + 1 : 32 - j;
#pragma unroll
              for (int q = 0; q < 4; ++q) { const int pp = p0 + q; const size_t ci = (((size_t)(l * 2 + dir) * 32 + g) * 16 + h) * 64 + pp;
                  const float cr = p.in[19][ci], cim = p.in[20][ci]; const f32x2 lm = gl[((size_t)(lg * 2 + dir) * 64 + pp) * 33 + e];
                  v[2 * q] = cr * lm.x - cim * lm.y; v[2 * q + 1] = -(cr * lm.y + cim * lm.x); }
          }
          u32x4 o; o.x = cvt_pk_bf16(v[0], v[1]); o.y = cvt_pk_bf16(v[2], v[3]); o.z = cvt_pk_bf16(v[4], v[5]); o.w = cvt_pk_bf16(v[6], v[7]);
          *(u32x4*)(YM + it * 8) = o; } }
    { const float* MOD = (const float*)(p.ws + WS_MOD); const float* pe = (const float*)(p.ws + WS_PE); bf16_t* H = (bf16_t*)(p.ws + WS_H);
      const int gw = w * 8 + (t >> 6), NW = G * 8;
      for (int r = gw; r < MTOT; r += NW) {
          if (r < NLAT) { const int b = r >> 11, tok = r & 2047; const float* mb = MOD + (size_t)b * 6144;
              row_pass(p.in[0] + (size_t)r * D, pe + (tok >> 6) * 512, pe + (32 + (tok & 63)) * 512, nullptr, nullptr, nullptr, p.out + (size_t)r * D, p.in[6], mb, mb + 1024, H + (size_t)r * D, lane); }
          else { const int rc = r - NLAT; const float* mb = MOD + (size_t)32 * 6144;
              row_pass(p.in[2] + (size_t)rc * D, nullptr, nullptr, nullptr, nullptr, nullptr, (float*)(p.ws + WS_XCTX) + (size_t)rc * D, p.in[6], mb, mb + 1024, H + (size_t)r * D, lane); }
      } }
}

__device__ void phase_post(const Params& p, int l, int which) {
    const int t = tid_l(), lane = t & 63, gw = blockIdx.x * 8 + (t >> 6), NW = gridDim.x * 8;
    const float* MOD = (const float*)(p.ws + WS_MOD) + (size_t)l * 33 * 6144; bf16_t* H = (bf16_t*)(p.ws + WS_H);
    const bf16_t* SRC = (const bf16_t*)(p.ws + (which == 0 ? WS_MOUT : WS_F));
    const int nrows = (l == 0) ? MTOT : NLAT;
    const float* wpost = (which == 0 ? p.in[7] : p.in[9]) + (size_t)l * D;
    const bool hasH = (which == 0) || (l == 0);
    const float* wpre = which == 0 ? p.in[8] + (size_t)l * D : p.in[6] + (size_t)(l + 1 < 2 ? l + 1 : 1) * D;
    const float* MODN = which == 0 ? MOD : (const float*)(p.ws + WS_MOD) + (size_t)(l + 1 < 2 ? l + 1 : 1) * 33 * 6144;
    for (int r = gw; r < nrows; r += NW) {
        const int b = r < NLAT ? (r >> 11) : 32;
        float* xr = r < NLAT ? p.out + (size_t)r * D : (float*)(p.ws + WS_XCTX) + (size_t)(r - NLAT) * D;
        const float* mb = MOD + (size_t)b * 6144; const float* mn = MODN + (size_t)b * 6144;
        const float* gate = mb + (which == 0 ? 2048 : 5120);
        const float* sh = mn + (which == 0 ? 3072 : 0); const float* sc = mn + (which == 0 ? 4096 : 1024);
        row_pass(xr, nullptr, nullptr, SRC + (size_t)r * D, wpost, gate, xr, wpre, sh, sc, hasH ? H + (size_t)r * D : nullptr, lane);
    }
}

__device__ void sgu_items(const Params& p, int l, LAS unsigned char* lds) {
    const int t = tid_l(), lane = t & 63, wv = t >> 6, fr = lane & 15, fq = lane >> 4;
    const bf16_t* Z = (const bf16_t*)(p.ws + WS_Z); bf16_t* CAT = (bf16_t*)(p.ws + WS_CAT);
    const bf16_t* SW = (const bf16_t*)(p.ws + WS_SGUW) + (size_t)l * 4 * 128 * 128; const float* sb = p.in[13] + (size_t)l * 4 * 128;
    LAS bf16_t* Vt = (LAS bf16_t*)lds;
    const int nitems = ((l == 0) ? MTOT : NLAT) / 128 * 4;
    for (int it = blockIdx.x; it < nitems; it += gridDim.x) {
        const int ck = it >> 2, h = it & 3;
        {
            const int q = t >> 2, part = t & 3; const bf16_t* vp = Z + (size_t)(ck * 128 + q) * DIN + 256 + 64 * h + part * 16;
            const u32x4 w0 = *(const u32x4*)vp, w1 = *(const u32x4*)(vp + 8);
            float v[16] = {bf_lo(w0.x), bf_hi(w0.x), bf_lo(w0.y), bf_hi(w0.y), bf_lo(w0.z), bf_hi(w0.z), bf_lo(w0.w), bf_hi(w0.w), bf_lo(w1.x), bf_hi(w1.x), bf_lo(w1.y), bf_hi(w1.y), bf_lo(w1.z), bf_hi(w1.z), bf_lo(w1.w), bf_hi(w1.w)};
            float s = 0.f;
#pragma unroll
            for (int i = 0; i < 16; ++i) s += v[i];
            s += __shfl_xor(s, 1); s += __shfl_xor(s, 2); const float mu = s * (1.0f / 64.0f); float q2 = 0.f;
#pragma unroll
            for (int i = 0; i < 16; ++i) { v[i] -= mu; q2 += v[i] * v[i]; }
            q2 += __shfl_xor(q2, 1); q2 += __shfl_xor(q2, 2); const float rstd = rsqrtf(q2 * (1.0f / 64.0f) + EPS);
#pragma unroll
            for (int i = 0; i < 16; ++i) Vt[(part * 16 + i) * 136 + q] = (bf16_t)(cvt_pk_bf16(v[i] * rstd, 0.f) & 0xffffu);
        }
        __syncthreads();
        f32x4 acc[4];
#pragma unroll
        for (int dt = 0; dt < 4; ++dt) acc[dt] = (f32x4){0.f, 0.f, 0.f, 0.f};
        const int p0 = 16 * wv;
#pragma unroll
        for (int kq = 0; kq < 4; ++kq) {
            const bf16x8 wf = *(const bf16x8*)(SW + ((size_t)h * 128 + p0 + fr) * 128 + kq * 32 + fq * 8);
#pragma unroll
            for (int dt = 0; dt < 4; ++dt) { const bf16x8 vf = *(const LAS bf16x8*)(Vt + (16 * dt + fr) * 136 + kq * 32 + fq * 8); acc[dt] = __builtin_amdgcn_mfma_f32_16x16x32_bf16(vf, wf, acc[dt], 0, 0, 0); }
        }
        {
            const int pt = p0 + fr; const float bias = sb[h * 128 + pt]; const size_t row = (size_t)ck * 128 + pt;
#pragma unroll
            for (int dt = 0; dt < 4; ++dt) { const int dcol = 64 * h + 16 * dt + 4 * fq; const u32x2 uw = *(const u32x2*)(Z + row * DIN + dcol);
                const float o0 = bf_lo(uw.x) * (acc[dt][0] + bias), o1 = bf_hi(uw.x) * (acc[dt][1] + bias), o2 = bf_lo(uw.y) * (acc[dt][2] + bias), o3 = bf_hi(uw.y) * (acc[dt][3] + bias);
                *(u32x2*)(CAT + row * D + dcol) = (u32x2){cvt_pk_bf16(o0, o1), cvt_pk_bf16(o2, o3)}; }
        }
        __syncthreads();
    }
}

__device__ void pool_items(const Params& p, int l, LAS unsigned char* lds) {
    const int t = tid_l(), lane = t & 63, wv = t >> 6, fr = lane & 15, fq = lane >> 4;
    const bf16_t* Z = (const bf16_t*)(p.ws + WS_Z); bf16_t* CAT = (bf16_t*)(p.ws + WS_CAT);
    const bf16_t* PW = (const bf16_t*)(p.ws + WS_POOLWT) + (size_t)l * 4 * 64 * 64; const float* psc = p.in[25] + (size_t)l * 256;
    LAS bf16_t* Pl = (LAS bf16_t*)lds;
    LAS bf16_t* Dl = Pl + 256 * 72;
    const int nitems = ((l == 0) ? MTOT : NLAT) / 256 * 4;
    for (int it = blockIdx.x; it < nitems; it += gridDim.x) {
        const int pt = it >> 2, i = it & 3, wdw = 2 << i;
        const int row = t >> 1, half = t & 1;
        { const bf16_t* src = Z + (size_t)(pt * 256 + row) * DIN + 1024 + 64 * i + half * 32;
#pragma unroll
          for (int q = 0; q < 4; ++q) *(LAS u32x4*)(Pl + row * 72 + half * 32 + q * 8) = *(const u32x4*)(src + q * 8); }
        __syncthreads();
        { const int seg = pt < 256 ? 64 : 256, pos = row & (seg - 1), sb = row - pos;
          int lo = pos - wdw / 2; int hi = lo + wdw; lo = lo < 0 ? 0 : lo; hi = hi > seg ? seg : hi; const float inv = 1.0f / (float)(hi - lo);
#pragma unroll
          for (int q = 0; q < 4; ++q) {
              float s[8];
#pragma unroll
              for (int e = 0; e < 8; ++e) s[e] = 0.f;
              for (int tau = lo; tau < hi; ++tau) { const u32x4 w = *(const LAS u32x4*)(Pl + (sb + tau) * 72 + half * 32 + q * 8);
                  s[0] += bf_lo(w.x); s[1] += bf_hi(w.x); s[2] += bf_lo(w.y); s[3] += bf_hi(w.y); s[4] += bf_lo(w.z); s[5] += bf_hi(w.z); s[6] += bf_lo(w.w); s[7] += bf_hi(w.w); }
              const u32x4 w = *(const LAS u32x4*)(Pl + row * 72 + half * 32 + q * 8);
              const float c[8] = {bf_lo(w.x), bf_hi(w.x), bf_lo(w.y), bf_hi(w.y), bf_lo(w.z), bf_hi(w.z), bf_lo(w.w), bf_hi(w.w)};
              u32x4 o; o.x = cvt_pk_bf16(s[0] * inv - c[0], s[1] * inv - c[1]); o.y = cvt_pk_bf16(s[2] * inv - c[2], s[3] * inv - c[3]);
              o.z = cvt_pk_bf16(s[4] * inv - c[4], s[5] * inv - c[5]); o.w = cvt_pk_bf16(s[6] * inv - c[6], s[7] * inv - c[7]);
              *(LAS u32x4*)(Dl + row * 72 + half * 32 + q * 8) = o; } }
        __syncthreads();
        f32x4 acc[2][4];
#pragma unroll
        for (int a = 0; a < 2; ++a)
#pragma unroll
            for (int o = 0; o < 4; ++o) acc[a][o] = (f32x4){0.f, 0.f, 0.f, 0.f};
#pragma unroll
        for (int kc = 0; kc < 2; ++kc) {
            bf16x8 df[2];
#pragma unroll
            for (int a = 0; a < 2; ++a) df[a] = *(const LAS bf16x8*)(Dl + (32 * wv + 16 * a + fr) * 72 + kc * 32 + fq * 8);
#pragma unroll
            for (int o = 0; o < 4; ++o) { const bf16x8 wf = *(const bf16x8*)(PW + ((size_t)i * 64 + 16 * o + fr) * 64 + kc * 32 + fq * 8);
#pragma unroll
                for (int a = 0; a < 2; ++a) acc[a][o] = __builtin_amdgcn_mfma_f32_16x16x32_bf16(wf, df[a], acc[a][o], 0, 0, 0); }
        }
#pragma unroll
        for (int a = 0; a < 2; ++a) { const size_t r = (size_t)pt * 256 + 32 * wv + 16 * a + fr;
#pragma unroll
            for (int o = 0; o < 4; ++o) { const int oc = 64 * i + 16 * o + 4 * fq; const f32x4 sc = *(const f32x4*)(psc + oc); const f32x4 v = acc[a][o] * sc;
                *(u32x2*)(CAT + r * D + 768 + oc) = (u32x2){cvt_pk_bf16(v[0], v[1]), cvt_pk_bf16(v[2], v[3])}; } }
        __syncthreads();
    }
}

__device__ void phase_scan(const Params& p, int l) {
    const size_t gt = (size_t)blockIdx.x * 512 + tid_l(), GT = (size_t)gridDim.x * 512;
    const float* S = (const float*)(p.ws + WS_S); bf16_t* U = (bf16_t*)(p.ws + WS_USSM); const f32x2* gl = (const f32x2*)(p.ws + WS_LAMP);
    for (size_t id = gt; id < (size_t)NB * 32 * 128; id += GT) {
        const int dp = (int)(id & 127), dir = dp >> 6, pp = dp & 63, g = (int)((id >> 7) & 31), b = (int)(id >> 12);
        const f32x2 lt = gl[((size_t)((l * 32 + g) * 2 + dir) * 64 + pp) * 33 + 32];
        float hr = 0.f, hi = 0.f;
        for (int st = 0; st < 72; ++st) {
            int bc;
            if (st < 8) bc = 2048 + 8 * b + (dir == 0 ? st : 7 - st);
            else bc = 64 * b + (dir == 0 ? st - 8 : 71 - st);
            const size_t rowi = (size_t)g * NBC + bc;
            const f32x2 sv = *(const f32x2*)(S + rowi * 256 + dir * 128 + 2 * pp);
            *(unsigned*)(U + rowi * KY + 512 + dir * 128 + 2 * pp) = cvt_pk_bf16(hr, hi);
            const float nr = lt.x * hr - lt.y * hi + sv.x, ni = lt.x * hi + lt.y * hr + sv.y;
            hr = nr; hi = ni;
        }
    }
}

__global__ void __launch_bounds__(512, 2) fwd_kernel(Params p) {
    extern __shared__ __attribute__((aligned(16))) unsigned char shm[];
    LAS unsigned char* lds = (LAS unsigned char*)shm;
    for (int ph = p.ph_lo; ph < p.ph_hi; ++ph) {
        unsigned char* ws = p.ws; asm volatile("" : "+s"(ws));
        if (ph == 0) phase_p0(p, lds);
        else if (ph == 1) phase_p1(p);
        else {
            const int l = (ph - 2) / 10, s = (ph - 2) % 10;
            const int nMall = (l == 0) ? MTOT / 256 : NLAT / 256;
            Sched S;
            if (s == 0) {
                GemmP g{(const bf16_t*)(ws + WS_H), (const bf16_t*)(ws + WS_WINT) + (size_t)l * DIN * D, D, D, D, 0, 0};
                if (l == 0) S.init(MTOT / 256, 5, 1, 0, 0, 0, 0); else S.init(NLAT / 256, 5, 1, NCTX / 256, 2, NLAT / 256, 2);
                EpiWin E{(bf16_t*)(ws + WS_Z), (bf16_t*)(ws + WS_USSM)};
                gemm_phase(lds, g, S, E);
            } else if (s == 1) {
                GemmP g{(const bf16_t*)(ws + WS_USSM), (const bf16_t*)(ws + WS_SMAT) + (size_t)l * 32 * 256 * KS, KY, KS, KS, (size_t)NBC * KY, (size_t)256 * KS};
                S.init(NBC / 256, 1, 32, 0, 0, 0, 0);
                EpiS E{(float*)(ws + WS_S)};
                gemm_phase(lds, g, S, E);
                __syncthreads();
                sgu_items(p, l, lds);
                pool_items(p, l, lds);
            } else if (s == 2) {
                phase_scan(p, l);
            } else if (s == 3) {
                GemmP g{(const bf16_t*)(ws + WS_USSM), (const bf16_t*)(ws + WS_YMAT) + (size_t)l * 32 * 512 * KY, KY, KY, KY, (size_t)NBC * KY, (size_t)512 * KY};
                S.init(l == 0 ? NBC / 256 : NLAT / TCH / 256, 2, 32, 0, 0, 0, 0);
                EpiY E{(bf16_t*)(ws + WS_Z)};
                gemm_phase(lds, g, S, E);
            } else if (s == 4) {
                GemmP g{(const bf16_t*)(ws + WS_Z) + 512, (const bf16_t*)(ws + WS_GLUT) + (size_t)l * 512 * 512, DIN, 512, 512, 0, 0};
                S.init(nMall, 2, 1, 0, 0, 0, 0);
                EpiGlu E{(const bf16_t*)(ws + WS_Z), (bf16_t*)(ws + WS_CAT), p.in[23] + (size_t)l * 512};
                gemm_phase(lds, g, S, E);
            } else if (s == 5) {
                GemmP g{(const bf16_t*)(ws + WS_CAT), (const bf16_t*)(ws + WS_WOUTT) + (size_t)l * D * D, D, D, D, 0, 0};
                S.init(nMall, 4, 1, 0, 0, 0, 0);
                EpiBf E{(bf16_t*)(ws + WS_MOUT), D};
                gemm_phase(lds, g, S, E);
            } else if (s == 6) {
                phase_post(p, l, 0);
            } else if (s == 7) {
                GemmP g{(const bf16_t*)(ws + WS_H), (const bf16_t*)(ws + WS_WGUT) + (size_t)l * 2 * DFF * D, D, D, D, 0, 0};
                S.init(nMall, 22, 1, 0, 0, 0, 0);
                EpiGU E{(bf16_t*)(ws + WS_HID)};
                gemm_phase(lds, g, S, E);
            } else if (s == 8) {
                GemmP g{(const bf16_t*)(ws + WS_HID), (const bf16_t*)(ws + WS_WDT) + (size_t)l * D * DFF, DFF, DFF, DFF, 0, 0};
                S.init(nMall, 4, 1, 0, 0, 0, 0);
                EpiBf E{(bf16_t*)(ws + WS_F), D};
                gemm_phase(lds, g, S, E);
            } else {
                phase_post(p, l, 1);
            }
        }
        if (p.sync && ph + 1 < p.ph_hi) { __threadfence(); cg::this_grid().sync(); }
    }
}

extern "C" void kernel_launch(void* const* d_in, const int* in_sizes, int n_in, void* d_out, int out_size, void* d_ws, size_t ws_size, hipStream_t stream) {
    static int grid = 0;
    if (grid == 0) {
        if (n_in != 29 || ws_size < WS_END) { fprintf(stderr, "kernel_launch: bad n_in %d or ws %zu < %zu\n", n_in, ws_size, (size_t)WS_END); grid = -1; return; }
        int dev = 0, cus = 0, per_cu = 0;
        hipGetDevice(&dev); hipDeviceGetAttribute(&cus, hipDeviceAttributeMultiprocessorCount, dev);
        if (hipFuncSetAttribute((const void*)fwd_kernel, hipFuncAttributeMaxDynamicSharedMemorySize, LDS_BYTES) != hipSuccess) { fprintf(stderr, "hipFuncSetAttribute failed\n"); grid = -1; return; }
        if (hipOccupancyMaxActiveBlocksPerMultiprocessor(&per_cu, (const void*)fwd_kernel, 512, LDS_BYTES) != hipSuccess || per_cu < 1) per_cu = 1;
        (void)hipGetLastError();
        grid = cus * 1;
    }
    if (grid < 0) return;
    Params p{};
    for (int i = 0; i < 29; ++i) p.in[i] = (const float*)d_in[i];
    p.out = (float*)d_out; p.ws = (unsigned char*)d_ws;
#if ONE_LAUNCH
    p.ph_lo = 0; p.ph_hi = NPH; p.sync = 1;
    void* args[] = {&p};
    hipError_t e = hipLaunchCooperativeKernel((const void*)fwd_kernel, dim3(grid), dim3(512), args, LDS_BYTES, stream);
    if (e != hipSuccess) fprintf(stderr, "cooperative launch failed: %s (grid %d)\n", hipGetErrorString(e), grid);
#else
    for (int ph = 0; ph < NPH; ++ph) {
        p.ph_lo = ph; p.ph_hi = ph + 1; p.sync = 0;
        hipLaunchKernelGGL(fwd_kernel, dim3(grid), dim3(512), LDS_BYTES, stream, p);
    }
#endif
}
```

```cpp
#include <hip/hip_runtime.h>
#include <hip/hip_cooperative_groups.h>
#include <cstdio>
#include <cstdint>
namespace cg = cooperative_groups;

#ifndef ONE_LAUNCH
#define ONE_LAUNCH 1
#endif

#define LAS __attribute__((address_space(3)))
typedef unsigned short bf16_t;
typedef short bf16x8 __attribute__((ext_vector_type(8)));
typedef float f32x4 __attribute__((ext_vector_type(4)));
typedef float f32x2 __attribute__((ext_vector_type(2)));
typedef unsigned u32x4 __attribute__((ext_vector_type(4)));
typedef unsigned u32x2 __attribute__((ext_vector_type(2)));

constexpr int D = 1024, NB = 32, SEQ = 2048, CTXL = 256, NLAT = NB * SEQ, NCTX = NB * CTXL, MTOT = NLAT + NCTX;
constexpr int DIN = 1280, DFF = 2816, TCH = 32  , NBC = MTOT / TCH  , KY = 768, KS = 512;
constexpr int NPH = 22;
constexpr int LDS_BYTES = 147456;
constexpr float EPS = 1e-6f;

constexpr size_t al256(size_t x) { return (x + 255) & ~(size_t)255; }
constexpr size_t WS_WINT = 0;
constexpr size_t WS_WOUTT = WS_WINT + al256((size_t)2 * DIN * D * 2);
constexpr size_t WS_GLUT = WS_WOUTT + al256((size_t)2 * D * D * 2);
constexpr size_t WS_WGUT = WS_GLUT + al256((size_t)2 * 512 * 512 * 2);
constexpr size_t WS_WDT = WS_WGUT + al256((size_t)2 * 2 * DFF * D * 2);
constexpr size_t WS_SGUW = WS_WDT + al256((size_t)2 * D * DFF * 2);
constexpr size_t WS_POOLWT = WS_SGUW + al256((size_t)2 * 4 * 128 * 128 * 2);
constexpr size_t WS_MOD = WS_POOLWT + al256((size_t)2 * 4 * 64 * 64 * 2);
constexpr size_t WS_PE = WS_MOD + al256((size_t)2 * 33 * 6144 * 4);
constexpr size_t WS_KT = WS_PE + al256((size_t)96 * 512 * 4);
constexpr size_t WS_LAMP = WS_KT + al256((size_t)2 * 32 * 2 * 32 * 256 * 4);
constexpr size_t WS_BBAR = WS_LAMP + al256((size_t)2 * 32 * 2 * 64 * 33 * 8);
constexpr size_t WS_SMAT = WS_BBAR + al256((size_t)2 * 32 * 2 * 64 * 16 * 8);
constexpr size_t WS_YMAT = WS_SMAT + al256((size_t)2 * 32 * 256 * 512 * 2);
constexpr size_t WS_XCTX = WS_YMAT + al256((size_t)2 * 32 * 512 * 768 * 2);
constexpr size_t WS_H = WS_XCTX + al256((size_t)NCTX * D * 4);
constexpr size_t WS_R = WS_H + al256((size_t)MTOT * D * 2);
constexpr size_t WS_Z = WS_R;
constexpr size_t WS_CAT = WS_Z + al256((size_t)MTOT * DIN * 2);
constexpr size_t WS_MOUT = WS_CAT + al256((size_t)MTOT * D * 2);
constexpr size_t WS_REND = WS_MOUT + al256((size_t)MTOT * D * 2);
constexpr size_t WS_HID = WS_R;
constexpr size_t WS_S = WS_MOUT;
constexpr size_t WS_USSM = WS_REND;
constexpr size_t WS_F = WS_USSM;
constexpr size_t WS_BAR = WS_USSM + al256((size_t)MTOT * D * 2);
constexpr size_t WS_END = WS_BAR + 16384;
static_assert((size_t)MTOT * DFF * 2 <= WS_REND - WS_R, "HID alias");
static_assert((size_t)32 * NBC * 256 * 4 <= (size_t)MTOT * D * 2, "S alias");
static_assert((size_t)32 * NBC * KY * 2 <= (size_t)MTOT * D * 2, "USSM alias");

struct Params {
    const float* in[29];
    float* out;
    unsigned char* ws;
    int ph_lo, ph_hi, sync, pad;
};

__device__ __forceinline__ unsigned cvt_pk_bf16(float lo, float hi) { unsigned r; asm volatile("v_cvt_pk_bf16_f32 %0, %1, %2" : "=v"(r) : "v"(lo), "v"(hi)); return r; }
__device__ __forceinline__ float bf_lo(unsigned w) { return __uint_as_float(w << 16); }
__device__ __forceinline__ float bf_hi(unsigned w) { return __uint_as_float(w & 0xffff0000u); }
__device__ __forceinline__ float gelu_t(float x) { const float u = 1.5957691216057308f * (x + 0.044715f * x * x * x); return __fdividef(x, 1.0f + __expf(-u)); }
__device__ __forceinline__ float silu_f(float x) { return __fdividef(x, 1.0f + __expf(-x)); }
__device__ __forceinline__ float sigmoid_f(float x) { return __fdividef(1.0f, 1.0f + __expf(-x)); }
__device__ __forceinline__ int tid_l() { int t = threadIdx.x; asm volatile("" : "+v"(t)); return t; }
__device__ __forceinline__ float wave_sum(float v) {
#pragma unroll
    for (int o = 1; o < 64; o <<= 1) v += __shfl_xor(v, o);
    return v;
}

constexpr int BM = 256, BK = 64, HALF = 128, HTB = HALF * BK * 2, NXCD = 8, WGM = 8;
__host__ __device__ __forceinline__ int lds_byte(int r, int c) { const int st = (r >> 4) * 2 + (c >> 5), rr = r & 15, cc = c & 31, ob = rr * 64 + cc * 2; return st * 1024 + (ob ^ (((ob >> 9) & 1) << 5)); }
__host__ __device__ __forceinline__ void stage_rc(int b, int& R, int& C) { const int st = b / 1024, sb = b % 1024, swz = sb ^ (((sb >> 9) & 1) << 5); R = (st >> 1) * 16 + swz / 64; C = (st & 1) * 32 + (swz % 64) / 2; }
__host__ __device__ __forceinline__ int perm32(int rho) { const int n = rho >> 4, i = rho & 15; return 8 * (i >> 2) + 4 * n + (i & 3); }

struct Unit { int pm, pn, g; };
struct GemmP { const bf16_t* A; const bf16_t* Bt; int lda, ldb, K; size_t gsA, gsB; };

struct Sched {
    int nM, nN, n1, nM2, nN2, pm2, pn2, total, G, c;
    __device__ void init(int nM_, int nN_, int nG_, int nM2_, int nN2_, int pm2_, int pn2_) {
        nM = nM_; nN = nN_; n1 = nM_ * nN_ * nG_; nM2 = nM2_; nN2 = nN2_; pm2 = pm2_; pn2 = pn2_; total = n1 + nM2_ * nN2_; G = (int)gridDim.x; c = (int)blockIdx.x;
    }
    __device__ __forceinline__ static void dec(int w, int nM_, int nN_, int& pm, int& pn) {
        const int nig = WGM * nN_, gid = w / nig, fm = gid * WGM, gsz = (nM_ - fm) < WGM ? (nM_ - fm) : WGM;
        pm = fm + ((w % nig) % gsz); pn = (w % nig) / gsz;
    }
    __device__ bool next(int i, Unit& u) const {
        const long L = (long)i * G + c; if (L >= total) return false;
        int w = (int)L; { const int q = total / NXCD, r = total % NXCD, xcd = w % NXCD, off = w / NXCD; w = (xcd < r ? xcd * (q + 1) : r * (q + 1) + (xcd - r) * q) + off; }
        if (w < n1) { const int per = nM * nN; u.g = w / per; dec(w % per, nM, nN, u.pm, u.pn); }
        else { u.g = 0; dec(w - n1, nM2, nN2, u.pm, u.pn); u.pm += pm2; u.pn += pn2; }
        return true;
    }
};

template <class Epi>
__device__ __forceinline__ void gemm_phase(LAS unsigned char* lds, const GemmP g, const Sched& S, const Epi& E) {
    const int tid = tid_l(), wid = __builtin_amdgcn_readfirstlane(tid >> 6), lane = tid & 63, wr = wid >> 2, wc = wid & 3, fr = lane & 15, fq = lane >> 4;
    const int nt = g.K / BK;
    unsigned voffA[2], voffB[2];
#pragma unroll
    for (int i = 0; i < 2; ++i) { int R, C; stage_rc(tid * 16 + i * 8192, R, C); const int Rb = (R & ~31) + perm32(R & 31);
        voffA[i] = (unsigned)(R * g.lda + C) * 2u; voffB[i] = (unsigned)(Rb * g.ldb + C) * 2u; }
    const size_t kstep = (size_t)(BK * 2);
    const size_t hstepA = (size_t)HALF * g.lda * 2, hstepB = (size_t)HALF * g.ldb * 2;
    const size_t tstepA = 2 * hstepA, tstepB = 2 * hstepB;
    const unsigned ldsw = (unsigned)wid * 1024u;
    const int aoff = lds_byte(wr * 64 + fr, fq * 8), boff = lds_byte(wc * 32 + fr, fq * 8);
#define PG8_SA(b, h) (((b) * 2 + (h)) * HTB)
#define PG8_SB(b, h) ((4 + (b) * 2 + (h)) * HTB)
#define PG8_STAGE(bufoff, gbase, voff) do { _Pragma("unroll") for (int _i = 0; _i < 2; ++_i) \
        __builtin_amdgcn_global_load_lds((const unsigned*)((const char*)(gbase) + (voff)[_i]), (LAS unsigned*)(lds + (bufoff) + ldsw + _i * 8192), 16, 0, 0); } while (0)
#define PG8_LDA(dst, b, h) do { _Pragma("unroll") for (int m = 0; m < 4; ++m) _Pragma("unroll") for (int k = 0; k < 2; ++k) dst[m][k] = *(const LAS bf16x8*)(lds + PG8_SA(b, h) + aoff + m * 2048 + k * 1024); } while (0)
#define PG8_LDB(dst, b, h) do { _Pragma("unroll") for (int n = 0; n < 2; ++n) _Pragma("unroll") for (int k = 0; k < 2; ++k) dst[n][k] = *(const LAS bf16x8*)(lds + PG8_SB(b, h) + boff + n * 2048 + k * 1024); } while (0)
#define PG8_MMA(ai, bj, At, Bt) do { __builtin_amdgcn_s_setprio(1); _Pragma("unroll") for (int m = 0; m < 4; ++m) _Pragma("unroll") for (int n = 0; n < 2; ++n) _Pragma("unroll") for (int k = 0; k < 2; ++k) \
        acc[ai][bj][m][n] = __builtin_amdgcn_mfma_f32_16x16x32_bf16(Bt[n][k], At[m][k], acc[ai][bj][m][n], 0, 0, 0); __builtin_amdgcn_s_setprio(0); } while (0)
#define PG8_WAIT_V(n) asm volatile("s_waitcnt vmcnt(" #n ")" ::: "memory")
#define PG8_WAIT_L(n) asm volatile("s_waitcnt lgkmcnt(" #n ")" ::: "memory")
#define PG8_BAR __builtin_amdgcn_s_barrier()
#define PG8_SCHED __builtin_amdgcn_sched_barrier(0)
    Unit cur, nxt; int ui = 0;
    if (!S.next(0, cur)) return;
    f32x4 acc[2][2][4][2];
#pragma unroll
    for (int a = 0; a < 2; ++a)
#pragma unroll
        for (int b = 0; b < 2; ++b)
#pragma unroll
            for (int m = 0; m < 4; ++m)
#pragma unroll
                for (int n = 0; n < 2; ++n) acc[a][b][m][n] = (f32x4){0.f, 0.f, 0.f, 0.f};
    bf16x8 At[4][2], B0[2][2], B1[2][2];
    const char* cA = (const char*)g.A + (size_t)cur.g * g.gsA * 2 + (size_t)cur.pm * tstepA;
    const char* cB = (const char*)g.Bt + (size_t)cur.g * g.gsB * 2 + (size_t)cur.pn * tstepB;
    PG8_STAGE(PG8_SB(0, 0), cB, voffB); PG8_STAGE(PG8_SA(0, 0), cA, voffA); PG8_STAGE(PG8_SB(0, 1), cB + hstepB, voffB); PG8_STAGE(PG8_SA(0, 1), cA + hstepA, voffA);
    if (wr == 1) PG8_BAR;
    PG8_WAIT_V(4); PG8_BAR;
    PG8_STAGE(PG8_SB(1, 0), cB + kstep, voffB); PG8_STAGE(PG8_SA(1, 0), cA + kstep, voffA); PG8_STAGE(PG8_SB(1, 1), cB + hstepB + kstep, voffB);
    PG8_WAIT_V(6); PG8_BAR;
    for (;;) {
        const bool has_next = S.next(ui + 1, nxt);
        const char* nA = has_next ? (const char*)g.A + (size_t)nxt.g * g.gsA * 2 + (size_t)nxt.pm * tstepA : cA;
        const char* nB = has_next ? (const char*)g.Bt + (size_t)nxt.g * g.gsB * 2 + (size_t)nxt.pn * tstepB : cB;
        for (int t = 0; t < nt; t += 2) {
            const bool last = (t == nt - 2);
            const char* a1 = cA + (size_t)(t + 1) * kstep;
            const char* a2 = last ? nA : cA + (size_t)(t + 2) * kstep; const char* b2 = last ? nB : cB + (size_t)(t + 2) * kstep;
            const char* a3 = a2 + kstep; const char* b3 = b2 + kstep;
            PG8_LDB(B0, 0, 0); PG8_SCHED; PG8_LDA(At, 0, 0); PG8_STAGE(PG8_SA(1, 1), a1 + hstepA, voffA);
            PG8_WAIT_L(8); PG8_BAR; PG8_WAIT_L(0); PG8_MMA(0, 0, At, B0); PG8_BAR; PG8_SCHED;
            PG8_LDB(B1, 0, 1); PG8_STAGE(PG8_SB(0, 0), b2, voffB);
            PG8_BAR; PG8_WAIT_L(0); PG8_MMA(0, 1, At, B1); PG8_BAR;
            PG8_LDA(At, 0, 1); PG8_STAGE(PG8_SA(0, 0), a2, voffA);
            PG8_BAR; PG8_WAIT_L(0); PG8_MMA(1, 0, At, B0); PG8_BAR; PG8_SCHED;
            PG8_STAGE(PG8_SB(0, 1), b2 + hstepB, voffB);
            PG8_WAIT_V(6); PG8_BAR; PG8_MMA(1, 1, At, B1); PG8_BAR;
            PG8_LDB(B0, 1, 0); PG8_SCHED; PG8_LDA(At, 1, 0); PG8_STAGE(PG8_SA(0, 1), a2 + hstepA, voffA);
            PG8_WAIT_L(8); PG8_BAR; PG8_WAIT_L(0); PG8_MMA(0, 0, At, B0); PG8_BAR; PG8_SCHED;
            PG8_LDB(B1, 1, 1); PG8_STAGE(PG8_SB(1, 0), b3, voffB);
            PG8_BAR; PG8_WAIT_L(0); PG8_MMA(0, 1, At, B1); PG8_BAR;
            PG8_LDA(At, 1, 1); PG8_STAGE(PG8_SA(1, 0), a3, voffA);
            PG8_BAR; PG8_WAIT_L(0); PG8_MMA(1, 0, At, B0); PG8_BAR; PG8_SCHED;
            PG8_STAGE(PG8_SB(1, 1), b3 + hstepB, voffB);
            PG8_WAIT_V(6); PG8_BAR; PG8_MMA(1, 1, At, B1); PG8_BAR;
        }
        E(acc, cur, wr, wc, fr, fq);
        if (!has_next) break;
#pragma unroll
        for (int a = 0; a < 2; ++a)
#pragma unroll
            for (int b = 0; b < 2; ++b)
#pragma unroll
                for (int m = 0; m < 4; ++m)
#pragma unroll
                    for (int n = 0; n < 2; ++n) acc[a][b][m][n] = (f32x4){0.f, 0.f, 0.f, 0.f};
        cur = nxt; cA = nA; cB = nB; ++ui;
    }
    PG8_WAIT_V(0);
    if (wr == 0) PG8_BAR;
    PG8_BAR;
#undef PG8_SA
#undef PG8_SB
#undef PG8_STAGE
#undef PG8_LDA
#undef PG8_LDB
#undef PG8_MMA
#undef PG8_WAIT_V
#undef PG8_WAIT_L
#undef PG8_BAR
#undef PG8_SCHED
}

__device__ __forceinline__ u32x4 pack8(const f32x4 a, const f32x4 b) { u32x4 w; w.x = cvt_pk_bf16(a[0], a[1]); w.y = cvt_pk_bf16(a[2], a[3]); w.z = cvt_pk_bf16(b[0], b[1]); w.w = cvt_pk_bf16(b[2], b[3]); return w; }

struct EpiWin {
    bf16_t* Z; bf16_t* U;
    __device__ __forceinline__ void operator()(const f32x4 (&acc)[2][2][4][2], const Unit& u, int wr, int wc, int fr, int fq) const {
        const int row0 = u.pm * BM + wr * 64 + fr;
#pragma unroll
        for (int ai = 0; ai < 2; ++ai)
#pragma unroll
            for (int m = 0; m < 4; ++m) {
                const int r = row0 + ai * HALF + m * 16;
#pragma unroll
                for (int bj = 0; bj < 2; ++bj) {
                    const int c0 = u.pn * BM + bj * HALF + wc * 32 + 8 * fq;
                    f32x4 v0 = acc[ai][bj][m][0], v1 = acc[ai][bj][m][1];
                    if (u.pn < 2) {
#pragma unroll
                        for (int j = 0; j < 4; ++j) { v0[j] = gelu_t(v0[j]); v1[j] = gelu_t(v1[j]); }
                        *(u32x4*)(Z + (size_t)r * DIN + c0) = pack8(v0, v1);
                    } else if (u.pn < 4) {
                        const int cc = c0 - 512, gg = cc >> 4, h0 = cc & 15;
                        *(u32x4*)(U + ((size_t)gg * NBC + (r >> 5)) * KY + (r & 31) * 16 + h0) = pack8(v0, v1);
                    } else {
                        *(u32x4*)(Z + (size_t)r * DIN + c0) = pack8(v0, v1);
                    }
                }
            }
    }
};
struct EpiS {
    float* S;
    __device__ __forceinline__ void operator()(const f32x4 (&acc)[2][2][4][2], const Unit& u, int wr, int wc, int fr, int fq) const {
        const int row0 = u.pm * BM + wr * 64 + fr;
#pragma unroll
        for (int ai = 0; ai < 2; ++ai)
#pragma unroll
            for (int m = 0; m < 4; ++m) {
                const int r = row0 + ai * HALF + m * 16;
                float* rp = S + ((size_t)u.g * NBC + r) * 256 + wc * 32 + 8 * fq;
#pragma unroll
                for (int bj = 0; bj < 2; ++bj) { *(f32x4*)(rp + bj * HALF) = acc[ai][bj][m][0]; *(f32x4*)(rp + bj * HALF + 4) = acc[ai][bj][m][1]; }
            }
    }
};
struct EpiY {
    bf16_t* Z;
    __device__ __forceinline__ void operator()(const f32x4 (&acc)[2][2][4][2], const Unit& u, int wr, int wc, int fr, int fq) const {
        const int row0 = u.pm * BM + wr * 64 + fr;
#pragma unroll
        for (int ai = 0; ai < 2; ++ai)
#pragma unroll
            for (int m = 0; m < 4; ++m) {
                const int bc = row0 + ai * HALF + m * 16;
#pragma unroll
                for (int bj = 0; bj < 2; ++bj) {
                    const int c0 = u.pn * BM + bj * HALF + wc * 32 + 8 * fq, j = c0 >> 4, h0 = c0 & 15;
                    f32x4 v0 = acc[ai][bj][m][0], v1 = acc[ai][bj][m][1];
#pragma unroll
                    for (int q = 0; q < 4; ++q) { v0[q] = gelu_t(v0[q]); v1[q] = gelu_t(v1[q]); }
                    *(u32x4*)(Z + ((size_t)bc * TCH + j) * DIN + 512 + u.g * 16 + h0) = pack8(v0, v1);
                }
            }
    }
};
struct EpiGlu {
    const bf16_t* Z; bf16_t* CAT; const float* bias;
    __device__ __forceinline__ void operator()(const f32x4 (&acc)[2][2][4][2], const Unit& u, int wr, int wc, int fr, int fq) const {
        const int row0 = u.pm * BM + wr * 64 + fr;
#pragma unroll
        for (int bj = 0; bj < 2; ++bj) {
            const int c0 = u.pn * BM + bj * HALF + wc * 32 + 8 * fq;
            const f32x4 b0 = *(const f32x4*)(bias + c0), b1 = *(const f32x4*)(bias + c0 + 4);
#pragma unroll
            for (int ai = 0; ai < 2; ++ai)
#pragma unroll
                for (int m = 0; m < 4; ++m) {
                    const int r = row0 + ai * HALF + m * 16;
                    const u32x4 gw = *(const u32x4*)(Z + (size_t)r * DIN + 512 + c0);
                    f32x4 v0 = acc[ai][bj][m][0] + b0, v1 = acc[ai][bj][m][1] + b1;
                    v0[0] = bf_lo(gw.x) * sigmoid_f(v0[0]); v0[1] = bf_hi(gw.x) * sigmoid_f(v0[1]); v0[2] = bf_lo(gw.y) * sigmoid_f(v0[2]); v0[3] = bf_hi(gw.y) * sigmoid_f(v0[3]);
                    v1[0] = bf_lo(gw.z) * sigmoid_f(v1[0]); v1[1] = bf_hi(gw.z) * sigmoid_f(v1[1]); v1[2] = bf_lo(gw.w) * sigmoid_f(v1[2]); v1[3] = bf_hi(gw.w) * sigmoid_f(v1[3]);
                    *(u32x4*)(CAT + (size_t)r * D + 256 + c0) = pack8(v0, v1);
                }
        }
    }
};
struct EpiBf {
    bf16_t* O; int ldc;
    __device__ __forceinline__ void operator()(const f32x4 (&acc)[2][2][4][2], const Unit& u, int wr, int wc, int fr, int fq) const {
        const int row0 = u.pm * BM + wr * 64 + fr, col0 = u.pn * BM + wc * 32 + 8 * fq;
#pragma unroll
        for (int ai = 0; ai < 2; ++ai)
#pragma unroll
            for (int m = 0; m < 4; ++m) {
                bf16_t* rp = O + (size_t)(row0 + ai * HALF + m * 16) * ldc + col0;
#pragma unroll
                for (int bj = 0; bj < 2; ++bj) *(u32x4*)(rp + bj * HALF) = pack8(acc[ai][bj][m][0], acc[ai][bj][m][1]);
            }
    }
};
struct EpiGU {
    bf16_t* HID;
    __device__ __forceinline__ void operator()(const f32x4 (&acc)[2][2][4][2], const Unit& u, int wr, int wc, int fr, int fq) const {
        const int row0 = u.pm * BM + wr * 64 + fr, col0 = u.pn * HALF + wc * 32 + 8 * fq;
#pragma unroll
        for (int ai = 0; ai < 2; ++ai)
#pragma unroll
            for (int m = 0; m < 4; ++m) {
                f32x4 v0, v1;
#pragma unroll
                for (int j = 0; j < 4; ++j) { v0[j] = silu_f(acc[ai][0][m][0][j]) * acc[ai][1][m][0][j]; v1[j] = silu_f(acc[ai][0][m][1][j]) * acc[ai][1][m][1][j]; }
                *(u32x4*)(HID + (size_t)(row0 + ai * HALF + m * 16) * DFF + col0) = pack8(v0, v1);
            }
    }
};

__device__ __forceinline__ void transpose_tile(const float* W, int K, int N, bf16_t* WT, int mode, int tile, LAS float* scr) {
    const int t = tid_l(), nblk = N / 64, kb = tile / nblk, nb = tile % nblk, k0 = kb * 64, n0 = nb * 64;
#pragma unroll
    for (int i = 0; i < 8; ++i) { const int idx = t + 512 * i, k = idx >> 6, n = idx & 63; scr[k * 65 + n] = W[(size_t)(k0 + k) * N + n0 + n]; }
    __syncthreads();
#pragma unroll
    for (int i = 0; i < 4; ++i) { const int idx = t + 512 * i, n = idx >> 5, kp = idx & 31;
        const int ncol = n0 + n; int drow = ncol;
        if (mode == 1) drow = 256 * (ncol >> 7) + (ncol & 127); else if (mode == 2) drow = 256 * (ncol >> 7) + 128 + (ncol & 127);
        *(unsigned*)(WT + (size_t)drow * K + k0 + 2 * kp) = cvt_pk_bf16(scr[(2 * kp) * 65 + n], scr[(2 * kp + 1) * 65 + n]); }
    __syncthreads();
}

__device__ void p0_mod_slab(const Params& p, int sl, LAS float* lds) {
    const int t = tid_l(), l = sl / 96, n0 = (sl % 96) * 64, col = t & 63, ks = t >> 6;
    const float* W = p.in[4] + (size_t)l * D * 6144; const float* bm = p.in[5] + (size_t)l * 6144;
    LAS float* sv = lds;
    LAS float* red = lds + 33 * 512;
    float acc[33];
#pragma unroll
    for (int b = 0; b < 33; ++b) acc[b] = 0.f;
    for (int half = 0; half < 2; ++half) {
        __syncthreads();
        for (int i = t; i < 33 * 512; i += 512) { const int b = i >> 9, k = (i & 511) + half * 512; const float cv = b < 32 ? p.in[1][b * D + k] : p.in[3][k]; sv[i] = silu_f(cv); }
        __syncthreads();
        for (int kk = 0; kk < 64; kk += 4) {
            const int kl = ks * 64 + kk, kg = half * 512 + kl;
            const float w0 = W[(size_t)(kg + 0) * 6144 + n0 + col], w1 = W[(size_t)(kg + 1) * 6144 + n0 + col], w2 = W[(size_t)(kg + 2) * 6144 + n0 + col], w3 = W[(size_t)(kg + 3) * 6144 + n0 + col];
#pragma unroll
            for (int b = 0; b < 33; ++b) { const f32x4 s = *(const LAS f32x4*)(sv + b * 512 + kl); acc[b] += s[0] * w0 + s[1] * w1 + s[2] * w2 + s[3] * w3; }
        }
    }
#pragma unroll
    for (int b = 0; b < 33; ++b) red[(ks * 33 + b) * 64 + col] = acc[b];
    __syncthreads();
    float* MOD = (float*)(p.ws + WS_MOD) + (size_t)l * 33 * 6144;
    for (int i = t; i < 33 * 64; i += 512) { const int b = i >> 6, cc = i & 63; float s = bm[n0 + cc];
#pragma unroll
        for (int k8 = 0; k8 < 8; ++k8) s += red[(k8 * 33 + b) * 64 + cc];
        MOD[(size_t)b * 6144 + n0 + cc] = s; }
    __syncthreads();
}

__device__ void p0_ssm_tables(const Params& p, int lg, LAS float* lds) {
    const int t = tid_l(), l = lg >> 5, g = lg & 31;
    LAS f32x2* lamp = (LAS f32x2*)lds;
    LAS f32x2* bbar = lamp + 2 * 64 * 33;
    LAS f32x2* cc = bbar + 2 * 64 * 16;
    f32x2* gl = (f32x2*)(p.ws + WS_LAMP) + (size_t)lg * 2 * 64 * 33;
    f32x2* gb = (f32x2*)(p.ws + WS_BBAR) + (size_t)lg * 2 * 64 * 16;
    __syncthreads();
    for (int i = t; i < 2 * 64 * 33; i += 512) {
        const int dir = i / (64 * 33), pp = (i / 33) % 64, n = i % 33;
        const size_t li = ((size_t)(l * 2 + dir) * 32 + g) * 64 + pp;
        const float dt = expf(p.in[16][(l * 2 + dir) * 32 + g]);
        const float a = p.in[14][li] * dt, b = p.in[15][li] * dt;
        const float mag = expf(a * (float)n); float sn, cs; sincosf(b * (float)n, &sn, &cs);
        const f32x2 v = {mag * cs, mag * sn}; lamp[i] = v; gl[i] = v;
    }
    for (int i = t; i < 2 * 64 * 16; i += 512) {
        const int dir = i / (64 * 16), pp = (i / 16) % 64, h = i % 16;
        const size_t li = ((size_t)(l * 2 + dir) * 32 + g) * 64 + pp;
        const float dt = expf(p.in[16][(l * 2 + dir) * 32 + g]);
        const float lr = p.in[14][li], lim = p.in[15][li];
        const float a = lr * dt, b = lim * dt;
        float sn, cs; sincosf(b, &sn, &cs); const float sh = sinf(0.5f * b);
        const float xr = expm1f(a) * cs - 2.0f * sh * sh, xi = expf(a) * sn;
        const float den = 1.0f / (lr * lr + lim * lim);
        const float qr = (xr * lr + xi * lim) * den, qi = (xi * lr - xr * lim) * den;
        const float br = p.in[17][li * 16 + h], bi = p.in[18][li * 16 + h];
        const f32x2 v = {qr * br - qi * bi, qr * bi + qi * br}; bbar[i] = v; gb[i] = v;
    }
    for (int i = t; i < 2 * 16 * 64; i += 512) {
        const int dir = i / 1024, h = (i / 64) % 16, pp = i % 64;
        const size_t ci = (((size_t)(l * 2 + dir) * 32 + g) * 16 + h) * 64 + pp;
        cc[i] = (f32x2){p.in[19][ci], p.in[20][ci]};
    }
    __syncthreads();
    float* KT = (float*)(p.ws + WS_KT) + (size_t)lg * 2 * 32 * 256;
    for (int e = t; e < 2 * 32 * 256; e += 512) {
        const int dir = e >> 13, n = (e >> 8) & 31, h = (e >> 4) & 15, hp = e & 15;
        float s = 0.f;
        for (int pp = 0; pp < 64; ++pp) {
            const f32x2 c = cc[(dir * 16 + h) * 64 + pp], lm = lamp[(dir * 64 + pp) * 33 + n], bb = bbar[(dir * 64 + pp) * 16 + hp];
            const float tr = c.x * lm.x - c.y * lm.y, ti = c.x * lm.y + c.y * lm.x;
            s += tr * bb.x - ti * bb.y;
        }
        KT[e] = s;
    }
    __syncthreads();
}

__device__ void phase_p0(const Params& p, LAS unsigned char* lds) {
    const int t = tid_l(), w = blockIdx.x, G = gridDim.x;
    if (w < 64) p0_ssm_tables(p, w, (LAS float*)lds);
    for (int sl = (w >= 64 ? w - 64 : w + G - 64); sl < 192; sl += G) p0_mod_slab(p, sl, (LAS float*)lds);
    {
        constexpr int T_IN = 16 * 20, T_OUT = 16 * 16, T_GLU = 8 * 8, T_G = 16 * 44, T_D = 44 * 16, T_L = T_IN + T_OUT + T_GLU + 2 * T_G + T_D;
        LAS float* scr = (LAS float*)lds;
        for (int it = w; it < 2 * T_L; it += G) {
            const int l = it / T_L; int r = it % T_L;
            if (r < T_IN) { transpose_tile(p.in[10] + (size_t)l * D * DIN, D, DIN, (bf16_t*)(p.ws + WS_WINT) + (size_t)l * DIN * D, 0, r, scr); continue; } r -= T_IN;
            if (r < T_OUT) { transpose_tile(p.in[11] + (size_t)l * D * D, D, D, (bf16_t*)(p.ws + WS_WOUTT) + (size_t)l * D * D, 0, r, scr); continue; } r -= T_OUT;
            if (r < T_GLU) { transpose_tile(p.in[22] + (size_t)l * 512 * 512, 512, 512, (bf16_t*)(p.ws + WS_GLUT) + (size_t)l * 512 * 512, 0, r, scr); continue; } r -= T_GLU;
            if (r < T_G) { transpose_tile(p.in[26] + (size_t)l * D * DFF, D, DFF, (bf16_t*)(p.ws + WS_WGUT) + (size_t)l * 2 * DFF * D, 1, r, scr); continue; } r -= T_G;
            if (r < T_G) { transpose_tile(p.in[27] + (size_t)l * D * DFF, D, DFF, (bf16_t*)(p.ws + WS_WGUT) + (size_t)l * 2 * DFF * D, 2, r, scr); continue; } r -= T_G;
            transpose_tile(p.in[28] + (size_t)l * DFF * D, DFF, D, (bf16_t*)(p.ws + WS_WDT) + (size_t)l * D * DFF, 0, r, scr);
        }
    }
    const int gt = w * 512 + t, GT = G * 512;
    { float* pe = (float*)(p.ws + WS_PE);
      for (int i = gt; i < 96 * 512; i += GT) { const int pos = i >> 9, cidx = i & 511, k = cidx & 255; const int ps = pos < 32 ? pos : pos - 32;
          const float om = expf(-9.210340371976184f * (float)k * (1.0f / 256.0f)); const float ang = (float)ps * om; pe[i] = cidx < 256 ? sinf(ang) : cosf(ang); } }
    { bf16_t* sw = (bf16_t*)(p.ws + WS_SGUW); for (int i = gt; i < 2 * 4 * 128 * 128 / 2; i += GT) *(unsigned*)(sw + 2 * i) = cvt_pk_bf16(p.in[12][2 * i], p.in[12][2 * i + 1]);
      bf16_t* pw = (bf16_t*)(p.ws + WS_POOLWT); for (int i = gt; i < 2 * 4 * 64 * 64; i += GT) { const int li = i >> 12, o = (i >> 6) & 63, ch = i & 63; pw[i] = (bf16_t)(cvt_pk_bf16(p.in[24][(size_t)li * 4096 + ch * 64 + o], 0.f) & 0xffffu); } }
}

__device__ __forceinline__ void row_pass(const float* xin, const float* per, const float* pec, const bf16_t* src, const float* wpost, const float* gate,
                                         float* xout, const float* wpre, const float* sh, const float* sc, bf16_t* hout, int lane) {
    f32x4 x[4];
#pragma unroll
    for (int j = 0; j < 4; ++j) x[j] = *(const f32x4*)(xin + 4 * lane + 256 * j);
    if (per) {
#pragma unroll
        for (int j = 0; j < 2; ++j) { x[j] += *(const f32x4*)(per + 4 * lane + 256 * j); x[j + 2] += *(const f32x4*)(pec + 4 * lane + 256 * j); }
    }
    if (src) {
        f32x4 s[4]; float ss = 0.f;
#pragma unroll
        for (int j = 0; j < 4; ++j) { const u32x2 w = *(const u32x2*)(src + 4 * lane + 256 * j); s[j] = (f32x4){bf_lo(w.x), bf_hi(w.x), bf_lo(w.y), bf_hi(w.y)}; ss += (s[j][0] * s[j][0] + s[j][1] * s[j][1]) + (s[j][2] * s[j][2] + s[j][3] * s[j][3]); }
        const float rstd = rsqrtf(wave_sum(ss) * (1.0f / D) + EPS);
#pragma unroll
        for (int j = 0; j < 4; ++j) { const f32x4 wv = *(const f32x4*)(wpost + 4 * lane + 256 * j), gv = *(const f32x4*)(gate + 4 * lane + 256 * j); x[j] += gv * (s[j] * rstd * wv); }
    }
    if (xout) {
#pragma unroll
        for (int j = 0; j < 4; ++j) *(f32x4*)(xout + 4 * lane + 256 * j) = x[j];
    }
    if (hout) {
        float ss = 0.f;
#pragma unroll
        for (int j = 0; j < 4; ++j) ss += (x[j][0] * x[j][0] + x[j][1] * x[j][1]) + (x[j][2] * x[j][2] + x[j][3] * x[j][3]);
        const float rstd = rsqrtf(wave_sum(ss) * (1.0f / D) + EPS);
#pragma unroll
        for (int j = 0; j < 4; ++j) { const f32x4 wv = *(const f32x4*)(wpre + 4 * lane + 256 * j), sv = *(const f32x4*)(sh + 4 * lane + 256 * j), cv = *(const f32x4*)(sc + 4 * lane + 256 * j);
            const f32x4 h = (x[j] * rstd * wv) * (1.0f + cv) + sv;
            *(u32x2*)(hout + 4 * lane + 256 * j) = (u32x2){cvt_pk_bf16(h[0], h[1]), cvt_pk_bf16(h[2], h[3])}; }
    }
}

__device__ void phase_p1(const Params& p) {
    const int t = tid_l(), w = blockIdx.x, G = gridDim.x, lane = t & 63;
    const size_t gt = (size_t)w * 512 + t, GT = (size_t)G * 512;
    { bf16_t* SM = (bf16_t*)(p.ws + WS_SMAT); const f32x2* gl = (const f32x2*)(p.ws + WS_LAMP); const f32x2* gb = (const f32x2*)(p.ws + WS_BBAR);
      for (size_t it = gt; it < (size_t)2 * 32 * 256 * 64; it += GT) {
          const int k8 = (int)(it & 63), n = (int)((it >> 6) & 255), lg = (int)(it >> 14);
          const int dir = n >> 7, pp = (n >> 1) & 63, ri = n & 1, s = k8 >> 1, h0 = (k8 & 1) * 8, e = dir == 0 ? 31 - s : s;
          const f32x2 lm = gl[((size_t)(lg * 2 + dir) * 64 + pp) * 33 + e]; const f32x2* bb = gb + ((size_t)(lg * 2 + dir) * 64 + pp) * 16 + h0;
          float v[8];
#pragma unroll
          for (int j = 0; j < 8; ++j) { const f32x2 b = bb[j]; v[j] = ri ? (lm.x * b.y + lm.y * b.x) : (lm.x * b.x - lm.y * b.y); }
          u32x4 o; o.x = cvt_pk_bf16(v[0], v[1]); o.y = cvt_pk_bf16(v[2], v[3]); o.z = cvt_pk_bf16(v[4], v[5]); o.w = cvt_pk_bf16(v[6], v[7]);
          *(u32x4*)(SM + it * 8) = o; } }
    { bf16_t* YM = (bf16_t*)(p.ws + WS_YMAT); const float* KT = (const float*)(p.ws + WS_KT); const f32x2* gl = (const f32x2*)(p.ws + WS_LAMP);
      for (size_t it = gt; it < (size_t)2 * 32 * 512 * 96; it += GT) {
          const int k8 = (int)(it % 96); const size_t rr = it / 96; const int row = (int)(rr & 511), lg = (int)(rr >> 9), l = lg >> 5, g = lg & 31, j = row >> 4, h = row & 15;
          float v[8];
          if (k8 < 64) {
              const int s = k8 >> 1, h0 = (k8 & 1) * 8, n = j - s;
              if (n > 0) { const float* kp = KT + (((size_t)lg * 2 + 0) * 32 + n) * 256 + h * 16 + h0;
#pragma unroll
                  for (int q = 0; q < 8; ++q) v[q] = kp[q]; }
              else if (n < 0) { const float* kp = KT + (((size_t)lg * 2 + 1) * 32 + (-n)) * 256 + h * 16 + h0;
#pragma unroll
                  for (int q = 0; q < 8; ++q) v[q] = kp[q]; }
              else { const float* k0 = KT + (((size_t)lg * 2 + 0) * 32) * 256 + h * 16 + h0; const float* k1 = KT + (((size_t)lg * 2 + 1) * 32) * 256 + h * 16 + h0; const float dd = p.in[21][(l * 32 + g) * 16 + h];
#pragma unroll
                  for (int q = 0; q < 8; ++q) v[q] = k0[q] + k1[q] + ((h0 + q) == h ? dd : 0.f); }
          } else {
              const int kk = (k8 - 64) * 8, dir = kk >> 7, p0 = (kk & 127) >> 1, e = dir == 0 ? j + 1 : 32 - j;
#pragma unroll
              for (int q = 0; q < 4; ++q) { const int pp = p0 + q; const size_t ci = (((size_t)(l * 2 + dir) * 32 + g) * 16 + h) * 64 + pp;
                  const float cr = p.in[19][ci], cim = p.in[20][ci]; const f32x2 lm = gl[((size_t)(lg * 2 + dir) * 64 + pp) * 33 + e];
                  v[2 * q] = cr * lm.x - cim * lm.y; v[2 * q + 1] = -(cr * lm.y + cim * lm.x); }
          }
          u32x4 o; o.x = cvt_pk_bf16(v[0], v[1]); o.y = cvt_pk_bf16(v[2], v[3]); o.z = cvt_pk_bf16(v[4], v[5]); o.w = cvt_pk_bf16(v[6], v[7]);
          *(u32x4*)(YM + it * 8) = o; } }
    { const float* MOD = (const float*)(p.ws + WS_MOD); const float* pe = (const float*)(p.ws + WS_PE); bf16_t* H = (bf16_t*)(p.ws + WS_H);
      const int gw = w * 8 + (t >> 6), NW = G * 8;
      for (int r = gw; r < MTOT; r += NW) {
          if (r < NLAT) { const int b = r >> 11, tok = r & 2047; const float* mb = MOD + (size_t)b * 6144;
              row_pass(p.in[0] + (size_t)r * D, pe + (tok >> 6) * 512, pe + (32 + (tok & 63)) * 512, nullptr, nullptr, nullptr, p.out + (size_t)r * D, p.in[6], mb, mb + 1024, H + (size_t)r * D, lane); }
          else { const int rc = r - NLAT; const float* mb = MOD + (size_t)32 * 6144;
              row_pass(p.in[2] + (size_t)rc * D, nullptr, nullptr, nullptr, nullptr, nullptr, (float*)(p.ws + WS_XCTX) + (size_t)rc * D, p.in[6], mb, mb + 1024, H + (size_t)r * D, lane); }
      } }
}

__device__ void phase_post(const Params& p, int l, int which) {
    const int t = tid_l(), lane = t & 63, gw = blockIdx.x * 8 + (t >> 6), NW = gridDim.x * 8;
    const float* MOD = (const float*)(p.ws + WS_MOD) + (size_t)l * 33 * 6144; bf16_t* H = (bf16_t*)(p.ws + WS_H);
    const bf16_t* SRC = (const bf16_t*)(p.ws + (which == 0 ? WS_MOUT : WS_F));
    const int nrows = (l == 0) ? MTOT : NLAT;
    const float* wpost = (which == 0 ? p.in[7] : p.in[9]) + (size_t)l * D;
    const bool hasH = (which == 0) || (l == 0);
    const float* wpre = which == 0 ? p.in[8] + (size_t)l * D : p.in[6] + (size_t)(l + 1 < 2 ? l + 1 : 1) * D;
    const float* MODN = which == 0 ? MOD : (const float*)(p.ws + WS_MOD) + (size_t)(l + 1 < 2 ? l + 1 : 1) * 33 * 6144;
    for (int r = gw; r < nrows; r += NW) {
        const int b = r < NLAT ? (r >> 11) : 32;
        float* xr = r < NLAT ? p.out + (size_t)r * D : (float*)(p.ws + WS_XCTX) + (size_t)(r - NLAT) * D;
        const float* mb = MOD + (size_t)b * 6144; const float* mn = MODN + (size_t)b * 6144;
        const float* gate = mb + (which == 0 ? 2048 : 5120);
        const float* sh = mn + (which == 0 ? 3072 : 0); const float* sc = mn + (which == 0 ? 4096 : 1024);
        row_pass(xr, nullptr, nullptr, SRC + (size_t)r * D, wpost, gate, xr, wpre, sh, sc, hasH ? H + (size_t)r * D : nullptr, lane);
    }
}

__device__ void sgu_items(const Params& p, int l, LAS unsigned char* lds) {
    const int t = tid_l(), lane = t & 63, wv = t >> 6, fr = lane & 15, fq = lane >> 4;
    const bf16_t* Z = (const bf16_t*)(p.ws + WS_Z); bf16_t* CAT = (bf16_t*)(p.ws + WS_CAT);
    const bf16_t* SW = (const bf16_t*)(p.ws + WS_SGUW) + (size_t)l * 4 * 128 * 128; const float* sb = p.in[13] + (size_t)l * 4 * 128;
    LAS bf16_t* Vt = (LAS bf16_t*)lds;
    const int nitems = ((l == 0) ? MTOT : NLAT) / 128 * 4;
    for (int it = blockIdx.x; it < nitems; it += gridDim.x) {
        const int ck = it >> 2, h = it & 3;
        {
            const int q = t >> 2, part = t & 3; const bf16_t* vp = Z + (size_t)(ck * 128 + q) * DIN + 256 + 64 * h + part * 16;
            const u32x4 w0 = *(const u32x4*)vp, w1 = *(const u32x4*)(vp + 8);
            float v[16] = {bf_lo(w0.x), bf_hi(w0.x), bf_lo(w0.y), bf_hi(w0.y), bf_lo(w0.z), bf_hi(w0.z), bf_lo(w0.w), bf_hi(w0.w), bf_lo(w1.x), bf_hi(w1.x), bf_lo(w1.y), bf_hi(w1.y), bf_lo(w1.z), bf_hi(w1.z), bf_lo(w1.w), bf_hi(w1.w)};
            float s = 0.f;
#pragma unroll
            for (int i = 0; i < 16; ++i) s += v[i];
            s += __shfl_xor(s, 1); s += __shfl_xor(s, 2); const float mu = s * (1.0f / 64.0f); float q2 = 0.f;
#pragma unroll
            for (int i = 0; i < 16; ++i) { v[i] -= mu; q2 += v[i] * v[i]; }
            q2 += __shfl_xor(q2, 1); q2 += __shfl_xor(q2, 2); const float rstd = rsqrtf(q2 * (1.0f / 64.0f) + EPS);
#pragma unroll
            for (int i = 0; i < 16; ++i) Vt[(part * 16 + i) * 136 + q] = (bf16_t)(cvt_pk_bf16(v[i] * rstd, 0.f) & 0xffffu);
        }
        __syncthreads();
        f32x4 acc[4];
#pragma unroll
        for (int dt = 0; dt < 4; ++dt) acc[dt] = (f32x4){0.f, 0.f, 0.f, 0.f};
        const int p0 = 16 * wv;
#pragma unroll
        for (int kq = 0; kq < 4; ++kq) {
            const bf16x8 wf = *(const bf16x8*)(SW + ((size_t)h * 128 + p0 + fr) * 128 + kq * 32 + fq * 8);
#pragma unroll
            for (int dt = 0; dt < 4; ++dt) { const bf16x8 vf = *(const LAS bf16x8*)(Vt + (16 * dt + fr) * 136 + kq * 32 + fq * 8); acc[dt] = __builtin_amdgcn_mfma_f32_16x16x32_bf16(vf, wf, acc[dt], 0, 0, 0); }
        }
        {
            const int pt = p0 + fr; const float bias = sb[h * 128 + pt]; const size_t row = (size_t)ck * 128 + pt;
#pragma unroll
            for (int dt = 0; dt < 4; ++dt) { const int dcol = 64 * h + 16 * dt + 4 * fq; const u32x2 uw = *(const u32x2*)(Z + row * DIN + dcol);
                const float o0 = bf_lo(uw.x) * (acc[dt][0] + bias), o1 = bf_hi(uw.x) * (acc[dt][1] + bias), o2 = bf_lo(uw.y) * (acc[dt][2] + bias), o3 = bf_hi(uw.y) * (acc[dt][3] + bias);
                *(u32x2*)(CAT + row * D + dcol) = (u32x2){cvt_pk_bf16(o0, o1), cvt_pk_bf16(o2, o3)}; }
        }
        __syncthreads();
    }
}

__device__ void pool_items(const Params& p, int l, LAS unsigned char* lds) {
    const int t = tid_l(), lane = t & 63, wv = t >> 6, fr = lane & 15, fq = lane >> 4;
    const bf16_t* Z = (const bf16_t*)(p.ws + WS_Z); bf16_t* CAT = (bf16_t*)(p.ws + WS_CAT);
    const bf16_t* PW = (const bf16_t*)(p.ws + WS_POOLWT) + (size_t)l * 4 * 64 * 64; const float* psc = p.in[25] + (size_t)l * 256;
    LAS bf16_t* Pl = (LAS bf16_t*)lds;
    LAS bf16_t* Dl = Pl + 256 * 72;
    const int nitems = ((l == 0) ? MTOT : NLAT) / 256 * 4;
    for (int it = blockIdx.x; it < nitems; it += gridDim.x) {
        const int pt = it >> 2, i = it & 3, wdw = 2 << i;
        const int row = t >> 1, half = t & 1;
        { const bf16_t* src = Z + (size_t)(pt * 256 + row) * DIN + 1024 + 64 * i + half * 32;
#pragma unroll
          for (int q = 0; q < 4; ++q) *(LAS u32x4*)(Pl + row * 72 + half * 32 + q * 8) = *(const u32x4*)(src + q * 8); }
        __syncthreads();
        { const int seg = pt < 256 ? 64 : 256, pos = row & (seg - 1), sb = row - pos;
          int lo = pos - wdw / 2; int hi = lo + wdw; lo = lo < 0 ? 0 : lo; hi = hi > seg ? seg : hi; const float inv = 1.0f / (float)(hi - lo);
#pragma unroll
          for (int q = 0; q < 4; ++q) {
              float s[8];
#pragma unroll
              for (int e = 0; e < 8; ++e) s[e] = 0.f;
              for (int tau = lo; tau < hi; ++tau) { const u32x4 w = *(const LAS u32x4*)(Pl + (sb + tau) * 72 + half * 32 + q * 8);
                  s[0] += bf_lo(w.x); s[1] += bf_hi(w.x); s[2] += bf_lo(w.y); s[3] += bf_hi(w.y); s[4] += bf_lo(w.z); s[5] += bf_hi(w.z); s[6] += bf_lo(w.w); s[7] += bf_hi(w.w); }
              const u32x4 w = *(const LAS u32x4*)(Pl + row * 72 + half * 32 + q * 8);
              const float c[8] = {bf_lo(w.x), bf_hi(w.x), bf_lo(w.y), bf_hi(w.y), bf_lo(w.z), bf_hi(w.z), bf_lo(w.w), bf_hi(w.w)};
              u32x4 o; o.x = cvt_pk_bf16(s[0] * inv - c[0], s[1] * inv - c[1]); o.y = cvt_pk_bf16(s[2] * inv - c[2], s[3] * inv - c[3]);
              o.z = cvt_pk_bf16(s[4] * inv - c[4], s[5] * inv - c[5]); o.w = cvt_pk_bf16(s[6] * inv - c[6], s[7] * inv - c[7]);
              *(LAS u32x4*)(Dl + row * 72 + half * 32 + q * 8) = o; } }
        __syncthreads();
        f32x4 acc[2][4];
#pragma unroll
        for (int a = 0; a < 2; ++a)
#pragma unroll
            for (int o = 0; o < 4; ++o) acc[a][o] = (f32x4){0.f, 0.f, 0.f, 0.f};
#pragma unroll
        for (int kc = 0; kc < 2; ++kc) {
            bf16x8 df[2];
#pragma unroll
            for (int a = 0; a < 2; ++a) df[a] = *(const LAS bf16x8*)(Dl + (32 * wv + 16 * a + fr) * 72 + kc * 32 + fq * 8);
#pragma unroll
            for (int o = 0; o < 4; ++o) { const bf16x8 wf = *(const bf16x8*)(PW + ((size_t)i * 64 + 16 * o + fr) * 64 + kc * 32 + fq * 8);
#pragma unroll
                for (int a = 0; a < 2; ++a) acc[a][o] = __builtin_amdgcn_mfma_f32_16x16x32_bf16(wf, df[a], acc[a][o], 0, 0, 0); }
        }
#pragma unroll
        for (int a = 0; a < 2; ++a) { const size_t r = (size_t)pt * 256 + 32 * wv + 16 * a + fr;
#pragma unroll
            for (int o = 0; o < 4; ++o) { const int oc = 64 * i + 16 * o + 4 * fq; const f32x4 sc = *(const f32x4*)(psc + oc); const f32x4 v = acc[a][o] * sc;
                *(u32x2*)(CAT + r * D + 768 + oc) = (u32x2){cvt_pk_bf16(v[0], v[1]), cvt_pk_bf16(v[2], v[3])}; } }
        __syncthreads();
    }
}

__device__ void phase_scan(const Params& p, int l) {
    const size_t gt = (size_t)blockIdx.x * 512 + tid_l(), GT = (size_t)gridDim.x * 512;
    const float* S = (const float*)(p.ws + WS_S); bf16_t* U = (bf16_t*)(p.ws + WS_USSM); const f32x2* gl = (const f32x2*)(p.ws + WS_LAMP);
    for (size_t id = gt; id < (size_t)NB * 32 * 128; id += GT) {
        const int dp = (int)(id & 127), dir = dp >> 6, pp = dp & 63, g = (int)((id >> 7) & 31), b = (int)(id >> 12);
        const f32x2 lt = gl[((size_t)((l * 32 + g) * 2 + dir) * 64 + pp) * 33 + 32];
        float hr = 0.f, hi = 0.f;
        for (int st = 0; st < 72; ++st) {
            int bc;
            if (st < 8) bc = 2048 + 8 * b + (dir == 0 ? st : 7 - st);
            else bc = 64 * b + (dir == 0 ? st - 8 : 71 - st);
            const size_t rowi = (size_t)g * NBC + bc;
            const f32x2 sv = *(const f32x2*)(S + rowi * 256 + dir * 128 + 2 * pp);
            *(unsigned*)(U + rowi * KY + 512 + dir * 128 + 2 * pp) = cvt_pk_bf16(hr, hi);
            const float nr = lt.x * hr - lt.y * hi + sv.x, ni = lt.x * hi + lt.y * hr + sv.y;
            hr = nr; hi = ni;
        }
    }
}

#define XB_TMO      128
#define XB_XCNT(j)  (256  + 64 * (j))
#define XB_XSUB(j)  (1280 + 64 * (j))
#define XB_XGEN(j)  (2304 + 64 * (j))
#define XB_TOP      3328
#define XB_TOPGEN   3392
#define XCD_BAR_WORDS 3456
#define XB_SPIN_CAP (1u << 22)
__device__ __forceinline__ unsigned xb_ld(unsigned* p)              { return __hip_atomic_load(p, __ATOMIC_RELAXED, __HIP_MEMORY_SCOPE_AGENT); }
__device__ __forceinline__ unsigned xb_add(unsigned* p, unsigned v) { return __hip_atomic_fetch_add(p, v, __ATOMIC_RELAXED, __HIP_MEMORY_SCOPE_AGENT); }
__device__ __forceinline__ unsigned xb_xcc_id() { return (unsigned)__builtin_amdgcn_s_getreg((3 << 11) | 20) & 0xFu; }
#define XB_SPIN(cond, bar) do { unsigned _sp = 0; while (cond) { __builtin_amdgcn_s_sleep(1); \
    if ((++_sp & 255u) == 0u) { if (xb_ld(&(bar)[XB_TMO])) break; if (_sp > XB_SPIN_CAP) { atomicAdd(&(bar)[XB_TMO], 1u); break; } } } } while (0)
struct XcdBarrier { unsigned* bar; unsigned x; volatile LAS unsigned* st; };
__device__ __forceinline__ XcdBarrier xcd_barrier_post(unsigned* bar, volatile LAS unsigned* st) {
    XcdBarrier b; b.bar = bar; b.x = xb_xcc_id(); b.st = st;
    if (threadIdx.x == 0) (void)xb_add(&bar[XB_XCNT(b.x)], 1u);
    return b;
}
__device__ __forceinline__ void xcd_barrier_complete(unsigned* bar, unsigned x, unsigned& nloc, unsigned& nx) {
    const unsigned G = gridDim.x * gridDim.y * gridDim.z;
    unsigned sum, cnt, mine, sp = 0u;
    for (;;) {
        sum = 0u; cnt = 0u; mine = 0u;
#pragma unroll
        for (unsigned j = 0; j < 16; ++j) { const unsigned c = xb_ld(&bar[XB_XCNT(j)]); sum += c; cnt += (c > 0u) ? 1u : 0u; mine = (j == x) ? c : mine; }
        if (sum == G) break;
        __builtin_amdgcn_s_sleep(1);
        if ((++sp & 255u) == 0u) { if (xb_ld(&bar[XB_TMO])) break; if (sp > XB_SPIN_CAP) { atomicAdd(&bar[XB_TMO], 1u); break; } }
    }
    nloc = mine > 0u ? mine : 1u; nx = cnt > 0u ? cnt : 1u;
}
__device__ __forceinline__ void xcd_barrier(const XcdBarrier& b) {
    asm volatile("s_waitcnt vmcnt(0)" ::: "memory");
    __syncthreads();
    if (threadIdx.x == 0) {
        unsigned* bar = b.bar;
        __builtin_amdgcn_s_waitcnt(0);
        unsigned nloc = b.st[0], nx = b.st[1];
        if (nloc == 0u) { xcd_barrier_complete(bar, b.x, nloc, nx); b.st[0] = nloc; b.st[1] = nx; }
        const unsigned old = xb_add(&bar[XB_XSUB(b.x)], 1u);
        const unsigned gen = old / nloc;
        if (old + 1u == (gen + 1u) * nloc) {
            __builtin_amdgcn_fence(__ATOMIC_RELEASE, "agent");
            asm volatile("s_waitcnt vmcnt(0)" ::: "memory");
            const unsigned og = xb_add(&bar[XB_TOP], 1u);
            const unsigned tg = og / nx;
            if (og + 1u == (tg + 1u) * nx) xb_add(&bar[XB_TOPGEN], 1u);
            else XB_SPIN(xb_ld(&bar[XB_TOPGEN]) == tg, bar);
            __builtin_amdgcn_fence(__ATOMIC_ACQUIRE, "agent");
            xb_add(&bar[XB_XGEN(b.x)], 1u);
            asm volatile("s_waitcnt vmcnt(0)" ::: "memory");
        } else {
            XB_SPIN(xb_ld(&bar[XB_XGEN(b.x)]) == gen, bar);
            __builtin_amdgcn_fence(__ATOMIC_ACQUIRE, "agent");
            asm volatile("s_waitcnt vmcnt(0)" ::: "memory");
        }
    }
    __syncthreads();
}

__global__ void __launch_bounds__(512, 2) fwd_kernel(Params p) {
    extern __shared__ __attribute__((aligned(16))) unsigned char shm[];
    LAS unsigned char* lds = (LAS unsigned char*)shm;
    volatile LAS unsigned* xst = (volatile LAS unsigned*)(lds + LDS_BYTES - 16);
    XcdBarrier xb; xb.bar = (unsigned*)(p.ws + WS_BAR); xb.x = 0; xb.st = xst;
    if (p.sync) { if (threadIdx.x == 0) { xst[0] = 0u; xst[1] = 0u; xst[2] = 0u; xst[3] = 0u; } __syncthreads(); xb = xcd_barrier_post((unsigned*)(p.ws + WS_BAR), xst); }
    for (int ph = p.ph_lo; ph < p.ph_hi; ++ph) {
        unsigned char* ws = p.ws; asm volatile("" : "+s"(ws));
        if (ph == 0) phase_p0(p, lds);
        else if (ph == 1) phase_p1(p);
        else {
            const int l = (ph - 2) / 10, s = (ph - 2) % 10;
            const int nMall = (l == 0) ? MTOT / 256 : NLAT / 256;
            Sched S;
            if (s == 0) {
                GemmP g{(const bf16_t*)(ws + WS_H), (const bf16_t*)(ws + WS_WINT) + (size_t)l * DIN * D, D, D, D, 0, 0};
                if (l == 0) S.init(MTOT / 256, 5, 1, 0, 0, 0, 0); else S.init(NLAT / 256, 5, 1, NCTX / 256, 2, NLAT / 256, 2);
                EpiWin E{(bf16_t*)(ws + WS_Z), (bf16_t*)(ws + WS_USSM)};
                gemm_phase(lds, g, S, E);
            } else if (s == 1) {
                GemmP g{(const bf16_t*)(ws + WS_USSM), (const bf16_t*)(ws + WS_SMAT) + (size_t)l * 32 * 256 * KS, KY, KS, KS, (size_t)NBC * KY, (size_t)256 * KS};
                S.init(NBC / 256, 1, 32, 0, 0, 0, 0);
                EpiS E{(float*)(ws + WS_S)};
                gemm_phase(lds, g, S, E);
                __syncthreads();
                sgu_items(p, l, lds);
                pool_items(p, l, lds);
            } else if (s == 2) {
                phase_scan(p, l);
            } else if (s == 3) {
                GemmP g{(const bf16_t*)(ws + WS_USSM), (const bf16_t*)(ws + WS_YMAT) + (size_t)l * 32 * 512 * KY, KY, KY, KY, (size_t)NBC * KY, (size_t)512 * KY};
                S.init(l == 0 ? NBC / 256 : NLAT / TCH / 256, 2, 32, 0, 0, 0, 0);
                EpiY E{(bf16_t*)(ws + WS_Z)};
                gemm_phase(lds, g, S, E);
            } else if (s == 4) {
                GemmP g{(const bf16_t*)(ws + WS_Z) + 512, (const bf16_t*)(ws + WS_GLUT) + (size_t)l * 512 * 512, DIN, 512, 512, 0, 0};
                S.init(nMall, 2, 1, 0, 0, 0, 0);
                EpiGlu E{(const bf16_t*)(ws + WS_Z), (bf16_t*)(ws + WS_CAT), p.in[23] + (size_t)l * 512};
                gemm_phase(lds, g, S, E);
            } else if (s == 5) {
                GemmP g{(const bf16_t*)(ws + WS_CAT), (const bf16_t*)(ws + WS_WOUTT) + (size_t)l * D * D, D, D, D, 0, 0};
                S.init(nMall, 4, 1, 0, 0, 0, 0);
                EpiBf E{(bf16_t*)(ws + WS_MOUT), D};
                gemm_phase(lds, g, S, E);
            } else if (s == 6) {
                phase_post(p, l, 0);
            } else if (s == 7) {
                GemmP g{(const bf16_t*)(ws + WS_H), (const bf16_t*)(ws + WS_WGUT) + (size_t)l * 2 * DFF * D, D, D, D, 0, 0};
                S.init(nMall, 22, 1, 0, 0, 0, 0);
                EpiGU E{(bf16_t*)(ws + WS_HID)};
                gemm_phase(lds, g, S, E);
            } else if (s == 8) {
                GemmP g{(const bf16_t*)(ws + WS_HID), (const bf16_t*)(ws + WS_WDT) + (size_t)l * D * DFF, DFF, DFF, DFF, 0, 0};
                S.init(nMall, 4, 1, 0, 0, 0, 0);
                EpiBf E{(bf16_t*)(ws + WS_F), D};
                gemm_phase(lds, g, S, E);
            } else {
                phase_post(p, l, 1);
            }
        }
        if (p.sync && ph + 1 < p.ph_hi) { if (ph == 0) cg::this_grid().sync(); else xcd_barrier(xb); }
    }
}

extern "C" void kernel_launch(void* const* d_in, const int* in_sizes, int n_in, void* d_out, int out_size, void* d_ws, size_t ws_size, hipStream_t stream) {
    static int grid = 0;
    if (grid == 0) {
        if (n_in != 29 || ws_size < WS_END) { fprintf(stderr, "kernel_launch: bad n_in %d or ws %zu < %zu\n", n_in, ws_size, (size_t)WS_END); grid = -1; return; }
        int dev = 0, cus = 0, per_cu = 0;
        hipGetDevice(&dev); hipDeviceGetAttribute(&cus, hipDeviceAttributeMultiprocessorCount, dev);
        if (hipFuncSetAttribute((const void*)fwd_kernel, hipFuncAttributeMaxDynamicSharedMemorySize, LDS_BYTES) != hipSuccess) { fprintf(stderr, "hipFuncSetAttribute failed\n"); grid = -1; return; }
        if (hipOccupancyMaxActiveBlocksPerMultiprocessor(&per_cu, (const void*)fwd_kernel, 512, LDS_BYTES) != hipSuccess || per_cu < 1) per_cu = 1;
        (void)hipGetLastError();
        grid = cus * 1;
    }
    if (grid < 0) return;
    Params p{};
    for (int i = 0; i < 29; ++i) p.in[i] = (const float*)d_in[i];
    p.out = (float*)d_out; p.ws = (unsigned char*)d_ws;
#if ONE_LAUNCH
    if (hipMemsetAsync((char*)d_ws + WS_BAR, 0, XCD_BAR_WORDS * 4, stream) != hipSuccess) { fprintf(stderr, "memset failed\n"); return; }
    p.ph_lo = 0; p.ph_hi = NPH; p.sync = 1;
    void* args[] = {&p};
    hipError_t e = hipLaunchCooperativeKernel((const void*)fwd_kernel, dim3(grid), dim3(512), args, LDS_BYTES, stream);
    if (e != hipSuccess) fprintf(stderr, "cooperative launch failed: %s (grid %d)\n", hipGetErrorString(e), grid);
#else
    for (int ph = 0; ph < NPH; ++ph) {
        p.ph_lo = ph; p.ph_hi = ph + 1; p.sync = 0;
        hipLaunchKernelGGL(fwd_kernel, dim3(grid), dim3(512), LDS_BYTES, stream, p);
    }
#endif
}
```

```cpp
#include <hip/hip_runtime.h>
#include <hip/hip_cooperative_groups.h>
#include <cstdio>
#include <cstdint>
namespace cg = cooperative_groups;

#ifndef GEMM_REP
#define GEMM_REP 1
#endif
#ifndef MIX_REP
#define MIX_REP 1
#endif
#ifndef ONE_LAUNCH
#define ONE_LAUNCH 1
#endif

#define LAS __attribute__((address_space(3)))
typedef unsigned short bf16_t;
typedef short bf16x8 __attribute__((ext_vector_type(8)));
typedef float f32x4 __attribute__((ext_vector_type(4)));
typedef float f32x2 __attribute__((ext_vector_type(2)));
typedef unsigned u32x4 __attribute__((ext_vector_type(4)));
typedef unsigned u32x2 __attribute__((ext_vector_type(2)));

constexpr int D = 1024, NB = 32, SEQ = 2048, CTXL = 256, NLAT = NB * SEQ, NCTX = NB * CTXL, MTOT = NLAT + NCTX;
constexpr int DIN = 1280, DFF = 2816, TCH = 32  , NBC = MTOT / TCH  , KY = 768, KS = 512;
constexpr int NPH = 22;
constexpr int LDS_BYTES = 147456;
constexpr float EPS = 1e-6f;

constexpr size_t al256(size_t x) { return (x + 255) & ~(size_t)255; }
constexpr size_t WS_WINT = 0;
constexpr size_t WS_WOUTT = WS_WINT + al256((size_t)2 * DIN * D * 2);
constexpr size_t WS_GLUT = WS_WOUTT + al256((size_t)2 * D * D * 2);
constexpr size_t WS_WGUT = WS_GLUT + al256((size_t)2 * 512 * 512 * 2);
constexpr size_t WS_WDT = WS_WGUT + al256((size_t)2 * 2 * DFF * D * 2);
constexpr size_t WS_SGUW = WS_WDT + al256((size_t)2 * D * DFF * 2);
constexpr size_t WS_POOLWT = WS_SGUW + al256((size_t)2 * 4 * 128 * 128 * 2);
constexpr size_t WS_MOD = WS_POOLWT + al256((size_t)2 * 4 * 64 * 64 * 2);
constexpr size_t WS_PE = WS_MOD + al256((size_t)2 * 33 * 6144 * 4);
constexpr size_t WS_KT = WS_PE + al256((size_t)96 * 512 * 4);
constexpr size_t WS_LAMP = WS_KT + al256((size_t)2 * 32 * 2 * 32 * 256 * 4);
constexpr size_t WS_BBAR = WS_LAMP + al256((size_t)2 * 32 * 2 * 64 * 33 * 8);
constexpr size_t WS_SMAT = WS_BBAR + al256((size_t)2 * 32 * 2 * 64 * 16 * 8);
constexpr size_t WS_YMAT = WS_SMAT + al256((size_t)2 * 32 * 256 * 512 * 2);
constexpr size_t WS_XCTX = WS_YMAT + al256((size_t)2 * 32 * 512 * 768 * 2);
constexpr size_t WS_H = WS_XCTX + al256((size_t)NCTX * D * 4);
constexpr size_t WS_R = WS_H + al256((size_t)MTOT * D * 2);
constexpr size_t WS_Z = WS_R;
constexpr size_t WS_CAT = WS_Z + al256((size_t)MTOT * DIN * 2);
constexpr size_t WS_MOUT = WS_CAT + al256((size_t)MTOT * D * 2);
constexpr size_t WS_REND = WS_MOUT + al256((size_t)MTOT * D * 2);
constexpr size_t WS_HID = WS_R;
constexpr size_t WS_S = WS_MOUT;
constexpr size_t WS_USSM = WS_REND;
constexpr size_t WS_F = WS_USSM;
constexpr size_t WS_BAR = WS_USSM + al256((size_t)MTOT * D * 2);
constexpr size_t WS_END = WS_BAR + 16384;
static_assert((size_t)MTOT * DFF * 2 <= WS_REND - WS_R, "HID alias");
static_assert((size_t)32 * NBC * 256 * 4 <= (size_t)MTOT * D * 2, "S alias");
static_assert((size_t)32 * NBC * KY * 2 <= (size_t)MTOT * D * 2, "USSM alias");

struct Params {
    const float* in[29];
    float* out;
    unsigned char* ws;
    int ph_lo, ph_hi, sync, pad;
};

__device__ __forceinline__ unsigned cvt_pk_bf16(float lo, float hi) { unsigned r; asm volatile("v_cvt_pk_bf16_f32 %0, %1, %2" : "=v"(r) : "v"(lo), "v"(hi)); return r; }
__device__ __forceinline__ float bf_lo(unsigned w) { return __uint_as_float(w << 16); }
__device__ __forceinline__ float bf_hi(unsigned w) { return __uint_as_float(w & 0xffff0000u); }
__device__ __forceinline__ float gelu_t(float x) { const float u = 1.5957691216057308f * (x + 0.044715f * x * x * x); return __fdividef(x, 1.0f + __expf(-u)); }
__device__ __forceinline__ float silu_f(float x) { return __fdividef(x, 1.0f + __expf(-x)); }
__device__ __forceinline__ float sigmoid_f(float x) { return __fdividef(1.0f, 1.0f + __expf(-x)); }
__device__ __forceinline__ int tid_l() { int t = threadIdx.x; asm volatile("" : "+v"(t)); return t; }
__device__ __forceinline__ float wave_sum(float v) {
#pragma unroll
    for (int o = 1; o < 64; o <<= 1) v += __shfl_xor(v, o);
    return v;
}

constexpr int BM = 256, BK = 64, HALF = 128, HTB = HALF * BK * 2, NXCD = 8, WGM = 8;
__host__ __device__ __forceinline__ int lds_byte(int r, int c) { const int st = (r >> 4) * 2 + (c >> 5), rr = r & 15, cc = c & 31, ob = rr * 64 + cc * 2; return st * 1024 + (ob ^ (((ob >> 9) & 1) << 5)); }
__host__ __device__ __forceinline__ void stage_rc(int b, int& R, int& C) { const int st = b / 1024, sb = b % 1024, swz = sb ^ (((sb >> 9) & 1) << 5); R = (st >> 1) * 16 + swz / 64; C = (st & 1) * 32 + (swz % 64) / 2; }
__host__ __device__ __forceinline__ int perm32(int rho) { const int n = rho >> 4, i = rho & 15; return 8 * (i >> 2) + 4 * n + (i & 3); }

struct Unit { int pm, pn, g; };
struct GemmP { const bf16_t* A; const bf16_t* Bt; int lda, ldb, K; size_t gsA, gsB; };

struct Sched {
    int nM, nN, n1, nM2, nN2, pm2, pn2, total, G, c;
    __device__ void init(int nM_, int nN_, int nG_, int nM2_, int nN2_, int pm2_, int pn2_) {
        nM = nM_; nN = nN_; n1 = nM_ * nN_ * nG_; nM2 = nM2_; nN2 = nN2_; pm2 = pm2_; pn2 = pn2_; total = n1 + nM2_ * nN2_; G = (int)gridDim.x; c = (int)blockIdx.x;
    }
    __device__ __forceinline__ static void dec(int w, int nM_, int nN_, int& pm, int& pn) {
        const int nig = WGM * nN_, gid = w / nig, fm = gid * WGM, gsz = (nM_ - fm) < WGM ? (nM_ - fm) : WGM;
        pm = fm + ((w % nig) % gsz); pn = (w % nig) / gsz;
    }
    __device__ bool next(int i, Unit& u) const {
        const long L = (long)i * G + c; if (L >= total) return false;
        int w = (int)L; { const int q = total / NXCD, r = total % NXCD, xcd = w % NXCD, off = w / NXCD; w = (xcd < r ? xcd * (q + 1) : r * (q + 1) + (xcd - r) * q) + off; }
        if (w < n1) { const int per = nM * nN; u.g = w / per; dec(w % per, nM, nN, u.pm, u.pn); }
        else { u.g = 0; dec(w - n1, nM2, nN2, u.pm, u.pn); u.pm += pm2; u.pn += pn2; }
        return true;
    }
};

template <class Epi>
__device__ __forceinline__ void gemm_phase(LAS unsigned char* lds, const GemmP g, const Sched& S, const Epi& E) {
    const int tid = tid_l(), wid = __builtin_amdgcn_readfirstlane(tid >> 6), lane = tid & 63, wr = wid >> 2, wc = wid & 3, fr = lane & 15, fq = lane >> 4;
    const int nt = g.K / BK;
    unsigned voffA[2], voffB[2];
#pragma unroll
    for (int i = 0; i < 2; ++i) { int R, C; stage_rc(tid * 16 + i * 8192, R, C); const int Rb = (R & ~31) + perm32(R & 31);
        voffA[i] = (unsigned)(R * g.lda + C) * 2u; voffB[i] = (unsigned)(Rb * g.ldb + C) * 2u; }
    const size_t kstep = (size_t)(BK * 2);
    const size_t hstepA = (size_t)HALF * g.lda * 2, hstepB = (size_t)HALF * g.ldb * 2;
    const size_t tstepA = 2 * hstepA, tstepB = 2 * hstepB;
    const unsigned ldsw = (unsigned)wid * 1024u;
    const int aoff = lds_byte(wr * 64 + fr, fq * 8), boff = lds_byte(wc * 32 + fr, fq * 8);
#define PG8_SA(b, h) (((b) * 2 + (h)) * HTB)
#define PG8_SB(b, h) ((4 + (b) * 2 + (h)) * HTB)
#define PG8_STAGE(bufoff, gbase, voff) do { _Pragma("unroll") for (int _i = 0; _i < 2; ++_i) \
        __builtin_amdgcn_global_load_lds((const unsigned*)((const char*)(gbase) + (voff)[_i]), (LAS unsigned*)(lds + (bufoff) + ldsw + _i * 8192), 16, 0, 0); } while (0)
#define PG8_LDA(dst, b, h) do { _Pragma("unroll") for (int m = 0; m < 4; ++m) _Pragma("unroll") for (int k = 0; k < 2; ++k) dst[m][k] = *(const LAS bf16x8*)(lds + PG8_SA(b, h) + aoff + m * 2048 + k * 1024); } while (0)
#define PG8_LDB(dst, b, h) do { _Pragma("unroll") for (int n = 0; n < 2; ++n) _Pragma("unroll") for (int k = 0; k < 2; ++k) dst[n][k] = *(const LAS bf16x8*)(lds + PG8_SB(b, h) + boff + n * 2048 + k * 1024); } while (0)
#define PG8_MMA(ai, bj, At, Bt) do { __builtin_amdgcn_s_setprio(1); _Pragma("unroll") for (int m = 0; m < 4; ++m) _Pragma("unroll") for (int n = 0; n < 2; ++n) _Pragma("unroll") for (int k = 0; k < 2; ++k) \
        acc[ai][bj][m][n] = __builtin_amdgcn_mfma_f32_16x16x32_bf16(Bt[n][k], At[m][k], acc[ai][bj][m][n], 0, 0, 0); __builtin_amdgcn_s_setprio(0); } while (0)
#define PG8_WAIT_V(n) asm volatile("s_waitcnt vmcnt(" #n ")" ::: "memory")
#define PG8_WAIT_L(n) asm volatile("s_waitcnt lgkmcnt(" #n ")" ::: "memory")
#define PG8_BAR __builtin_amdgcn_s_barrier()
#define PG8_SCHED __builtin_amdgcn_sched_barrier(0)
    Unit cur, nxt; int ui = 0;
    if (!S.next(0, cur)) return;
    f32x4 acc[2][2][4][2];
#pragma unroll
    for (int a = 0; a < 2; ++a)
#pragma unroll
        for (int b = 0; b < 2; ++b)
#pragma unroll
            for (int m = 0; m < 4; ++m)
#pragma unroll
                for (int n = 0; n < 2; ++n) acc[a][b][m][n] = (f32x4){0.f, 0.f, 0.f, 0.f};
    bf16x8 At[4][2], B0[2][2], B1[2][2];
    const char* cA = (const char*)g.A + (size_t)cur.g * g.gsA * 2 + (size_t)cur.pm * tstepA;
    const char* cB = (const char*)g.Bt + (size_t)cur.g * g.gsB * 2 + (size_t)cur.pn * tstepB;
    PG8_STAGE(PG8_SB(0, 0), cB, voffB); PG8_STAGE(PG8_SA(0, 0), cA, voffA); PG8_STAGE(PG8_SB(0, 1), cB + hstepB, voffB); PG8_STAGE(PG8_SA(0, 1), cA + hstepA, voffA);
    if (wr == 1) PG8_BAR;
    PG8_WAIT_V(4); PG8_BAR;
    PG8_STAGE(PG8_SB(1, 0), cB + kstep, voffB); PG8_STAGE(PG8_SA(1, 0), cA + kstep, voffA); PG8_STAGE(PG8_SB(1, 1), cB + hstepB + kstep, voffB);
    PG8_WAIT_V(6); PG8_BAR;
    for (;;) {
        const bool has_next = S.next(ui + 1, nxt);
        const char* nA = has_next ? (const char*)g.A + (size_t)nxt.g * g.gsA * 2 + (size_t)nxt.pm * tstepA : cA;
        const char* nB = has_next ? (const char*)g.Bt + (size_t)nxt.g * g.gsB * 2 + (size_t)nxt.pn * tstepB : cB;
        for (int t = 0; t < nt; t += 2) {
            const bool last = (t == nt - 2);
            const char* a1 = cA + (size_t)(t + 1) * kstep;
            const char* a2 = last ? nA : cA + (size_t)(t + 2) * kstep; const char* b2 = last ? nB : cB + (size_t)(t + 2) * kstep;
            const char* a3 = a2 + kstep; const char* b3 = b2 + kstep;
            PG8_LDB(B0, 0, 0); PG8_SCHED; PG8_LDA(At, 0, 0); PG8_STAGE(PG8_SA(1, 1), a1 + hstepA, voffA);
            PG8_WAIT_L(8); PG8_BAR; PG8_WAIT_L(0); PG8_MMA(0, 0, At, B0); PG8_BAR; PG8_SCHED;
            PG8_LDB(B1, 0, 1); PG8_STAGE(PG8_SB(0, 0), b2, voffB);
            PG8_BAR; PG8_WAIT_L(0); PG8_MMA(0, 1, At, B1); PG8_BAR;
            PG8_LDA(At, 0, 1); PG8_STAGE(PG8_SA(0, 0), a2, voffA);
            PG8_BAR; PG8_WAIT_L(0); PG8_MMA(1, 0, At, B0); PG8_BAR; PG8_SCHED;
            PG8_STAGE(PG8_SB(0, 1), b2 + hstepB, voffB);
            PG8_WAIT_V(6); PG8_BAR; PG8_MMA(1, 1, At, B1); PG8_BAR;
            PG8_LDB(B0, 1, 0); PG8_SCHED; PG8_LDA(At, 1, 0); PG8_STAGE(PG8_SA(0, 1), a2 + hstepA, voffA);
            PG8_WAIT_L(8); PG8_BAR; PG8_WAIT_L(0); PG8_MMA(0, 0, At, B0); PG8_BAR; PG8_SCHED;
            PG8_LDB(B1, 1, 1); PG8_STAGE(PG8_SB(1, 0), b3, voffB);
            PG8_BAR; PG8_WAIT_L(0); PG8_MMA(0, 1, At, B1); PG8_BAR;
            PG8_LDA(At, 1, 1); PG8_STAGE(PG8_SA(1, 0), a3, voffA);
            PG8_BAR; PG8_WAIT_L(0); PG8_MMA(1, 0, At, B0); PG8_BAR; PG8_SCHED;
            PG8_STAGE(PG8_SB(1, 1), b3 + hstepB, voffB);
            PG8_WAIT_V(6); PG8_BAR; PG8_MMA(1, 1, At, B1); PG8_BAR;
        }
        E(acc, cur, wr, wc, fr, fq);
        if (!has_next) break;
#pragma unroll
        for (int a = 0; a < 2; ++a)
#pragma unroll
            for (int b = 0; b < 2; ++b)
#pragma unroll
                for (int m = 0; m < 4; ++m)
#pragma unroll
                    for (int n = 0; n < 2; ++n) acc[a][b][m][n] = (f32x4){0.f, 0.f, 0.f, 0.f};
        cur = nxt; cA = nA; cB = nB; ++ui;
    }
    PG8_WAIT_V(0);
    if (wr == 0) PG8_BAR;
    PG8_BAR;
#undef PG8_SA
#undef PG8_SB
#undef PG8_STAGE
#undef PG8_LDA
#undef PG8_LDB
#undef PG8_MMA
#undef PG8_WAIT_V
#undef PG8_WAIT_L
#undef PG8_BAR
#undef PG8_SCHED
}

__device__ __forceinline__ u32x4 pack8(const f32x4 a, const f32x4 b) { u32x4 w; w.x = cvt_pk_bf16(a[0], a[1]); w.y = cvt_pk_bf16(a[2], a[3]); w.z = cvt_pk_bf16(b[0], b[1]); w.w = cvt_pk_bf16(b[2], b[3]); return w; }

struct EpiWin {
    bf16_t* Z; bf16_t* U;
    __device__ __forceinline__ void operator()(const f32x4 (&acc)[2][2][4][2], const Unit& u, int wr, int wc, int fr, int fq) const {
        const int row0 = u.pm * BM + wr * 64 + fr;
#pragma unroll
        for (int ai = 0; ai < 2; ++ai)
#pragma unroll
            for (int m = 0; m < 4; ++m) {
                const int r = row0 + ai * HALF + m * 16;
#pragma unroll
                for (int bj = 0; bj < 2; ++bj) {
                    const int c0 = u.pn * BM + bj * HALF + wc * 32 + 8 * fq;
                    f32x4 v0 = acc[ai][bj][m][0], v1 = acc[ai][bj][m][1];
                    if (u.pn < 2) {
#pragma unroll
                        for (int j = 0; j < 4; ++j) { v0[j] = gelu_t(v0[j]); v1[j] = gelu_t(v1[j]); }
                        *(u32x4*)(Z + (size_t)r * DIN + c0) = pack8(v0, v1);
                    } else if (u.pn < 4) {
                        const int cc = c0 - 512, gg = cc >> 4, h0 = cc & 15;
                        *(u32x4*)(U + ((size_t)gg * NBC + (r >> 5)) * KY + (r & 31) * 16 + h0) = pack8(v0, v1);
                    } else {
                        *(u32x4*)(Z + (size_t)r * DIN + c0) = pack8(v0, v1);
                    }
                }
            }
    }
};
struct EpiS {
    float* S;
    __device__ __forceinline__ void operator()(const f32x4 (&acc)[2][2][4][2], const Unit& u, int wr, int wc, int fr, int fq) const {
        const int row0 = u.pm * BM + wr * 64 + fr;
#pragma unroll
        for (int ai = 0; ai < 2; ++ai)
#pragma unroll
            for (int m = 0; m < 4; ++m) {
                const int r = row0 + ai * HALF + m * 16;
                float* rp = S + ((size_t)u.g * NBC + r) * 256 + wc * 32 + 8 * fq;
#pragma unroll
                for (int bj = 0; bj < 2; ++bj) { *(f32x4*)(rp + bj * HALF) = acc[ai][bj][m][0]; *(f32x4*)(rp + bj * HALF + 4) = acc[ai][bj][m][1]; }
            }
    }
};
struct EpiY {
    bf16_t* Z;
    __device__ __forceinline__ void operator()(const f32x4 (&acc)[2][2][4][2], const Unit& u, int wr, int wc, int fr, int fq) const {
        const int row0 = u.pm * BM + wr * 64 + fr;
#pragma unroll
        for (int ai = 0; ai < 2; ++ai)
#pragma unroll
            for (int m = 0; m < 4; ++m) {
                const int bc = row0 + ai * HALF + m * 16;
#pragma unroll
                for (int bj = 0; bj < 2; ++bj) {
                    const int c0 = u.pn * BM + bj * HALF + wc * 32 + 8 * fq, j = c0 >> 4, h0 = c0 & 15;
                    f32x4 v0 = acc[ai][bj][m][0], v1 = acc[ai][bj][m][1];
#pragma unroll
                    for (int q = 0; q < 4; ++q) { v0[q] = gelu_t(v0[q]); v1[q] = gelu_t(v1[q]); }
                    *(u32x4*)(Z + ((size_t)bc * TCH + j) * DIN + 512 + u.g * 16 + h0) = pack8(v0, v1);
                }
            }
    }
};
struct EpiGlu {
    const bf16_t* Z; bf16_t* CAT; const float* bias;
    __device__ __forceinline__ void operator()(const f32x4 (&acc)[2][2][4][2], const Unit& u, int wr, int wc, int fr, int fq) const {
        const int row0 = u.pm * BM + wr * 64 + fr;
#pragma unroll
        for (int bj = 0; bj < 2; ++bj) {
            const int c0 = u.pn * BM + bj * HALF + wc * 32 + 8 * fq;
            const f32x4 b0 = *(const f32x4*)(bias + c0), b1 = *(const f32x4*)(bias + c0 + 4);
#pragma unroll
            for (int ai = 0; ai < 2; ++ai)
#pragma unroll
                for (int m = 0; m < 4; ++m) {
                    const int r = row0 + ai * HALF + m * 16;
                    const u32x4 gw = *(const u32x4*)(Z + (size_t)r * DIN + 512 + c0);
                    f32x4 v0 = acc[ai][bj][m][0] + b0, v1 = acc[ai][bj][m][1] + b1;
                    v0[0] = bf_lo(gw.x) * sigmoid_f(v0[0]); v0[1] = bf_hi(gw.x) * sigmoid_f(v0[1]); v0[2] = bf_lo(gw.y) * sigmoid_f(v0[2]); v0[3] = bf_hi(gw.y) * sigmoid_f(v0[3]);
                    v1[0] = bf_lo(gw.z) * sigmoid_f(v1[0]); v1[1] = bf_hi(gw.z) * sigmoid_f(v1[1]); v1[2] = bf_lo(gw.w) * sigmoid_f(v1[2]); v1[3] = bf_hi(gw.w) * sigmoid_f(v1[3]);
                    *(u32x4*)(CAT + (size_t)r * D + 256 + c0) = pack8(v0, v1);
                }
        }
    }
};
struct EpiBf {
    bf16_t* O; int ldc;
    __device__ __forceinline__ void operator()(const f32x4 (&acc)[2][2][4][2], const Unit& u, int wr, int wc, int fr, int fq) const {
        const int row0 = u.pm * BM + wr * 64 + fr, col0 = u.pn * BM + wc * 32 + 8 * fq;
#pragma unroll
        for (int ai = 0; ai < 2; ++ai)
#pragma unroll
            for (int m = 0; m < 4; ++m) {
                bf16_t* rp = O + (size_t)(row0 + ai * HALF + m * 16) * ldc + col0;
#pragma unroll
                for (int bj = 0; bj < 2; ++bj) *(u32x4*)(rp + bj * HALF) = pack8(acc[ai][bj][m][0], acc[ai][bj][m][1]);
            }
    }
};
struct EpiGU {
    bf16_t* HID;
    __device__ __forceinline__ void operator()(const f32x4 (&acc)[2][2][4][2], const Unit& u, int wr, int wc, int fr, int fq) const {
        const int row0 = u.pm * BM + wr * 64 + fr, col0 = u.pn * HALF + wc * 32 + 8 * fq;
#pragma unroll
        for (int ai = 0; ai < 2; ++ai)
#pragma unroll
            for (int m = 0; m < 4; ++m) {
                f32x4 v0, v1;
#pragma unroll
                for (int j = 0; j < 4; ++j) { v0[j] = silu_f(acc[ai][0][m][0][j]) * acc[ai][1][m][0][j]; v1[j] = silu_f(acc[ai][0][m][1][j]) * acc[ai][1][m][1][j]; }
                *(u32x4*)(HID + (size_t)(row0 + ai * HALF + m * 16) * DFF + col0) = pack8(v0, v1);
            }
    }
};

__device__ __forceinline__ void transpose_tile(const float* W, int K, int N, bf16_t* WT, int mode, int tile, LAS float* scr) {
    const int t = tid_l(), nblk = N / 64, kb = tile / nblk, nb = tile % nblk, k0 = kb * 64, n0 = nb * 64;
#pragma unroll
    for (int i = 0; i < 8; ++i) { const int idx = t + 512 * i, k = idx >> 6, n = idx & 63; scr[k * 65 + n] = W[(size_t)(k0 + k) * N + n0 + n]; }
    __syncthreads();
#pragma unroll
    for (int i = 0; i < 4; ++i) { const int idx = t + 512 * i, n = idx >> 5, kp = idx & 31;
        const int ncol = n0 + n; int drow = ncol;
        if (mode == 1) drow = 256 * (ncol >> 7) + (ncol & 127); else if (mode == 2) drow = 256 * (ncol >> 7) + 128 + (ncol & 127);
        *(unsigned*)(WT + (size_t)drow * K + k0 + 2 * kp) = cvt_pk_bf16(scr[(2 * kp) * 65 + n], scr[(2 * kp + 1) * 65 + n]); }
    __syncthreads();
}

__device__ void p0_mod_slab(const Params& p, int sl, LAS float* lds) {
    const int t = tid_l(), l = sl / 96, n0 = (sl % 96) * 64, col = t & 63, ks = t >> 6;
    const float* W = p.in[4] + (size_t)l * D * 6144; const float* bm = p.in[5] + (size_t)l * 6144;
    LAS float* sv = lds;
    LAS float* red = lds + 33 * 512;
    float acc[33];
#pragma unroll
    for (int b = 0; b < 33; ++b) acc[b] = 0.f;
    for (int half = 0; half < 2; ++half) {
        __syncthreads();
        for (int i = t; i < 33 * 512; i += 512) { const int b = i >> 9, k = (i & 511) + half * 512; const float cv = b < 32 ? p.in[1][b * D + k] : p.in[3][k]; sv[i] = silu_f(cv); }
        __syncthreads();
        for (int kk = 0; kk < 64; kk += 4) {
            const int kl = ks * 64 + kk, kg = half * 512 + kl;
            const float w0 = W[(size_t)(kg + 0) * 6144 + n0 + col], w1 = W[(size_t)(kg + 1) * 6144 + n0 + col], w2 = W[(size_t)(kg + 2) * 6144 + n0 + col], w3 = W[(size_t)(kg + 3) * 6144 + n0 + col];
#pragma unroll
            for (int b = 0; b < 33; ++b) { const f32x4 s = *(const LAS f32x4*)(sv + b * 512 + kl); acc[b] += s[0] * w0 + s[1] * w1 + s[2] * w2 + s[3] * w3; }
        }
    }
#pragma unroll
    for (int b = 0; b < 33; ++b) red[(ks * 33 + b) * 64 + col] = acc[b];
    __syncthreads();
    float* MOD = (float*)(p.ws + WS_MOD) + (size_t)l * 33 * 6144;
    for (int i = t; i < 33 * 64; i += 512) { const int b = i >> 6, cc = i & 63; float s = bm[n0 + cc];
#pragma unroll
        for (int k8 = 0; k8 < 8; ++k8) s += red[(k8 * 33 + b) * 64 + cc];
        MOD[(size_t)b * 6144 + n0 + cc] = s; }
    __syncthreads();
}

__device__ void p0_ssm_tables(const Params& p, int lg, LAS float* lds) {
    const int t = tid_l(), l = lg >> 5, g = lg & 31;
    LAS f32x2* lamp = (LAS f32x2*)lds;
    LAS f32x2* bbar = lamp + 2 * 64 * 33;
    LAS f32x2* cc = bbar + 2 * 64 * 16;
    f32x2* gl = (f32x2*)(p.ws + WS_LAMP) + (size_t)lg * 2 * 64 * 33;
    f32x2* gb = (f32x2*)(p.ws + WS_BBAR) + (size_t)lg * 2 * 64 * 16;
    __syncthreads();
    for (int i = t; i < 2 * 64 * 33; i += 512) {
        const int dir = i / (64 * 33), pp = (i / 33) % 64, n = i % 33;
        const size_t li = ((size_t)(l * 2 + dir) * 32 + g) * 64 + pp;
        const float dt = expf(p.in[16][(l * 2 + dir) * 32 + g]);
        const float a = p.in[14][li] * dt, b = p.in[15][li] * dt;
        const float mag = expf(a * (float)n); float sn, cs; sincosf(b * (float)n, &sn, &cs);
        const f32x2 v = {mag * cs, mag * sn}; lamp[i] = v; gl[i] = v;
    }
    for (int i = t; i < 2 * 64 * 16; i += 512) {
        const int dir = i / (64 * 16), pp = (i / 16) % 64, h = i % 16;
        const size_t li = ((size_t)(l * 2 + dir) * 32 + g) * 64 + pp;
        const float dt = expf(p.in[16][(l * 2 + dir) * 32 + g]);
        const float lr = p.in[14][li], lim = p.in[15][li];
        const float a = lr * dt, b = lim * dt;
        float sn, cs; sincosf(b, &sn, &cs); const float sh = sinf(0.5f * b);
        const float xr = expm1f(a) * cs - 2.0f * sh * sh, xi = expf(a) * sn;
        const float den = 1.0f / (lr * lr + lim * lim);
        const float qr = (xr * lr + xi * lim) * den, qi = (xi * lr - xr * lim) * den;
        const float br = p.in[17][li * 16 + h], bi = p.in[18][li * 16 + h];
        const f32x2 v = {qr * br - qi * bi, qr * bi + qi * br}; bbar[i] = v; gb[i] = v;
    }
    for (int i = t; i < 2 * 16 * 64; i += 512) {
        const int dir = i / 1024, h = (i / 64) % 16, pp = i % 64;
        const size_t ci = (((size_t)(l * 2 + dir) * 32 + g) * 16 + h) * 64 + pp;
        cc[i] = (f32x2){p.in[19][ci], p.in[20][ci]};
    }
    __syncthreads();
    float* KT = (float*)(p.ws + WS_KT) + (size_t)lg * 2 * 32 * 256;
    for (int e = t; e < 2 * 32 * 256; e += 512) {
        const int dir = e >> 13, n = (e >> 8) & 31, h = (e >> 4) & 15, hp = e & 15;
        float s = 0.f;
        for (int pp = 0; pp < 64; ++pp) {
            const f32x2 c = cc[(dir * 16 + h) * 64 + pp], lm = lamp[(dir * 64 + pp) * 33 + n], bb = bbar[(dir * 64 + pp) * 16 + hp];
            const float tr = c.x * lm.x - c.y * lm.y, ti = c.x * lm.y + c.y * lm.x;
            s += tr * bb.x - ti * bb.y;
        }
        KT[e] = s;
    }
    __syncthreads();
}

__device__ void phase_p0(const Params& p, LAS unsigned char* lds) {
    const int t = tid_l(), w = blockIdx.x, G = gridDim.x;
    if (w < 64) p0_ssm_tables(p, w, (LAS float*)lds);
    for (int sl = (w >= 64 ? w - 64 : w + G - 64); sl < 192; sl += G) p0_mod_slab(p, sl, (LAS float*)lds);
    {
        constexpr int T_IN = 16 * 20, T_OUT = 16 * 16, T_GLU = 8 * 8, T_G = 16 * 44, T_D = 44 * 16, T_L = T_IN + T_OUT + T_GLU + 2 * T_G + T_D;
        LAS float* scr = (LAS float*)lds;
        for (int it = w; it < 2 * T_L; it += G) {
            const int l = it / T_L; int r = it % T_L;
            if (r < T_IN) { transpose_tile(p.in[10] + (size_t)l * D * DIN, D, DIN, (bf16_t*)(p.ws + WS_WINT) + (size_t)l * DIN * D, 0, r, scr); continue; } r -= T_IN;
            if (r < T_OUT) { transpose_tile(p.in[11] + (size_t)l * D * D, D, D, (bf16_t*)(p.ws + WS_WOUTT) + (size_t)l * D * D, 0, r, scr); continue; } r -= T_OUT;
            if (r < T_GLU) { transpose_tile(p.in[22] + (size_t)l * 512 * 512, 512, 512, (bf16_t*)(p.ws + WS_GLUT) + (size_t)l * 512 * 512, 0, r, scr); continue; } r -= T_GLU;
            if (r < T_G) { transpose_tile(p.in[26] + (size_t)l * D * DFF, D, DFF, (bf16_t*)(p.ws + WS_WGUT) + (size_t)l * 2 * DFF * D, 1, r, scr); continue; } r -= T_G;
            if (r < T_G) { transpose_tile(p.in[27] + (size_t)l * D * DFF, D, DFF, (bf16_t*)(p.ws + WS_WGUT) + (size_t)l * 2 * DFF * D, 2, r, scr); continue; } r -= T_G;
            transpose_tile(p.in[28] + (size_t)l * DFF * D, DFF, D, (bf16_t*)(p.ws + WS_WDT) + (size_t)l * D * DFF, 0, r, scr);
        }
    }
    const int gt = w * 512 + t, GT = G * 512;
    { float* pe = (float*)(p.ws + WS_PE);
      for (int i = gt; i < 96 * 512; i += GT) { const int pos = i >> 9, cidx = i & 511, k = cidx & 255; const int ps = pos < 32 ? pos : pos - 32;
          const float om = expf(-9.210340371976184f * (float)k * (1.0f / 256.0f)); const float ang = (float)ps * om; pe[i] = cidx < 256 ? sinf(ang) : cosf(ang); } }
    { bf16_t* sw = (bf16_t*)(p.ws + WS_SGUW); for (int i = gt; i < 2 * 4 * 128 * 128 / 2; i += GT) *(unsigned*)(sw + 2 * i) = cvt_pk_bf16(p.in[12][2 * i], p.in[12][2 * i + 1]);
      bf16_t* pw = (bf16_t*)(p.ws + WS_POOLWT); for (int i = gt; i < 2 * 4 * 64 * 64; i += GT) { const int li = i >> 12, o = (i >> 6) & 63, ch = i & 63; pw[i] = (bf16_t)(cvt_pk_bf16(p.in[24][(size_t)li * 4096 + ch * 64 + o], 0.f) & 0xffffu); } }
}

struct RowIn { f32x4 x[4]; f32x4 pe[4]; u32x2 s[4]; };
template <bool PE, bool SRC>
__device__ __forceinline__ void row_load(RowIn& d, const float* xin, const float* per, const float* pec, const bf16_t* src, int lane) {
#pragma unroll
    for (int j = 0; j < 4; ++j) d.x[j] = *(const f32x4*)(xin + 4 * lane + 256 * j);
    if (PE) {
#pragma unroll
        for (int j = 0; j < 2; ++j) { d.pe[j] = *(const f32x4*)(per + 4 * lane + 256 * j); d.pe[j + 2] = *(const f32x4*)(pec + 4 * lane + 256 * j); }
    }
    if (SRC) {
#pragma unroll
        for (int j = 0; j < 4; ++j) d.s[j] = *(const u32x2*)(src + 4 * lane + 256 * j);
    }
}
template <bool PE, bool SRC, bool XOUT, bool HOUT>
__device__ __forceinline__ void row_compute(const RowIn& d, const f32x4 (&Av)[4], const f32x4 (&Bv)[4], const f32x4 (&Cv)[4], float* xout, bf16_t* hout, int lane) {
    f32x4 x[4];
#pragma unroll
    for (int j = 0; j < 4; ++j) { x[j] = d.x[j]; if (PE) x[j] += d.pe[j]; }
    if (SRC) {
        f32x4 s[4]; float ss = 0.f;
#pragma unroll
        for (int j = 0; j < 4; ++j) { s[j] = (f32x4){bf_lo(d.s[j].x), bf_hi(d.s[j].x), bf_lo(d.s[j].y), bf_hi(d.s[j].y)}; ss += (s[j][0] * s[j][0] + s[j][1] * s[j][1]) + (s[j][2] * s[j][2] + s[j][3] * s[j][3]); }
        const float rstd = rsqrtf(wave_sum(ss) * (1.0f / D) + EPS);
#pragma unroll
        for (int j = 0; j < 4; ++j) x[j] += Av[j] * (s[j] * rstd);
    }
    if (XOUT) {
#pragma unroll
        for (int j = 0; j < 4; ++j) *(f32x4*)(xout + 4 * lane + 256 * j) = x[j];
    }
    if (HOUT) {
        float ss = 0.f;
#pragma unroll
        for (int j = 0; j < 4; ++j) ss += (x[j][0] * x[j][0] + x[j][1] * x[j][1]) + (x[j][2] * x[j][2] + x[j][3] * x[j][3]);
        const float rstd = rsqrtf(wave_sum(ss) * (1.0f / D) + EPS);
#pragma unroll
        for (int j = 0; j < 4; ++j) { const f32x4 h = (x[j] * rstd) * Bv[j] + Cv[j];
            *(u32x2*)(hout + 4 * lane + 256 * j) = (u32x2){cvt_pk_bf16(h[0], h[1]), cvt_pk_bf16(h[2], h[3])}; }
    }
}
template <bool PE, bool SRC, bool XOUT, bool HOUT>
__device__ __forceinline__ void rows_run(const float* xin, const float* pe, int tok0, const bf16_t* src, float* xout, bf16_t* hout, int nr,
                                         const f32x4 (&Av)[4], const f32x4 (&Bv)[4], const f32x4 (&Cv)[4], int lane) {
    RowIn cur, nxt;
    row_load<PE, SRC>(cur, xin, PE ? pe + (tok0 >> 6) * 512 : nullptr, PE ? pe + (32 + (tok0 & 63)) * 512 : nullptr, src, lane);
    for (int i = 0; i < nr; ++i) {
        if (i + 1 < nr) { const int tk = tok0 + i + 1;
            row_load<PE, SRC>(nxt, xin + (size_t)(i + 1) * D, PE ? pe + (tk >> 6) * 512 : nullptr, PE ? pe + (32 + (tk & 63)) * 512 : nullptr, SRC ? src + (size_t)(i + 1) * D : nullptr, lane); }
        row_compute<PE, SRC, XOUT, HOUT>(cur, Av, Bv, Cv, XOUT ? xout + (size_t)i * D : nullptr, HOUT ? hout + (size_t)i * D : nullptr, lane);
        cur = nxt;
    }
}
__device__ __forceinline__ void row_vecs(f32x4 (&Av)[4], f32x4 (&Bv)[4], f32x4 (&Cv)[4], const float* gate, const float* wpost, const float* wpre, const float* sh, const float* sc, int lane) {
#pragma unroll
    for (int j = 0; j < 4; ++j) { const int o = 4 * lane + 256 * j;
        Av[j] = gate ? *(const f32x4*)(gate + o) * *(const f32x4*)(wpost + o) : (f32x4){0.f, 0.f, 0.f, 0.f};
        if (wpre) { Bv[j] = *(const f32x4*)(wpre + o) * (1.0f + *(const f32x4*)(sc + o)); Cv[j] = *(const f32x4*)(sh + o); } else { Bv[j] = (f32x4){0.f, 0.f, 0.f, 0.f}; Cv[j] = Bv[j]; } }
}

__device__ void phase_p1(const Params& p) {
    const int t = tid_l(), w = blockIdx.x, G = gridDim.x, lane = t & 63;
    const size_t gt = (size_t)w * 512 + t, GT = (size_t)G * 512;
    { bf16_t* SM = (bf16_t*)(p.ws + WS_SMAT); const f32x2* gl = (const f32x2*)(p.ws + WS_LAMP); const f32x2* gb = (const f32x2*)(p.ws + WS_BBAR);
      for (size_t it = gt; it < (size_t)2 * 32 * 256 * 64; it += GT) {
          const int k8 = (int)(it & 63), n = (int)((it >> 6) & 255), lg = (int)(it >> 14);
          const int dir = n >> 7, pp = (n >> 1) & 63, ri = n & 1, s = k8 >> 1, h0 = (k8 & 1) * 8, e = dir == 0 ? 31 - s : s;
          const f32x2 lm = gl[((size_t)(lg * 2 + dir) * 64 + pp) * 33 + e]; const f32x2* bb = gb + ((size_t)(lg * 2 + dir) * 64 + pp) * 16 + h0;
          float v[8];
#pragma unroll
          for (int j = 0; j < 8; ++j) { const f32x2 b = bb[j]; v[j] = ri ? (lm.x * b.y + lm.y * b.x) : (lm.x * b.x - lm.y * b.y); }
          u32x4 o; o.x = cvt_pk_bf16(v[0], v[1]); o.y = cvt_pk_bf16(v[2], v[3]); o.z = cvt_pk_bf16(v[4], v[5]); o.w = cvt_pk_bf16(v[6], v[7]);
          *(u32x4*)(SM + it * 8) = o; } }
    { bf16_t* YM = (bf16_t*)(p.ws + WS_YMAT); const float* KT = (const float*)(p.ws + WS_KT); const f32x2* gl = (const f32x2*)(p.ws + WS_LAMP);
      for (size_t it = gt; it < (size_t)2 * 32 * 512 * 96; it += GT) {
          const int k8 = (int)(it % 96); const size_t rr = it / 96; const int row = (int)(rr & 511), lg = (int)(rr >> 9), l = lg >> 5, g = lg & 31, j = row >> 4, h = row & 15;
          float v[8];
          if (k8 < 64) {
              const int s = k8 >> 1, h0 = (k8 & 1) * 8, n = j - s;
              if (n > 0) { const float* kp = KT + (((size_t)lg * 2 + 0) * 32 + n) * 256 + h * 16 + h0;
#pragma unroll
                  for (int q = 0; q < 8; ++q) v[q] = kp[q]; }
              else if (n < 0) { const float* kp = KT + (((size_t)lg * 2 + 1) * 32 + (-n)) * 256 + h * 16 + h0;
#pragma unroll
                  for (int q = 0; q < 8; ++q) v[q] = kp[q]; }
              else { const float* k0 = KT + (((size_t)lg * 2 + 0) * 32) * 256 + h * 16 + h0; const float* k1 = KT + (((size_t)lg * 2 + 1) * 32) * 256 + h * 16 + h0; const float dd = p.in[21][(l * 32 + g) * 16 + h];
#pragma unroll
                  for (int q = 0; q < 8; ++q) v[q] = k0[q] + k1[q] + ((h0 + q) == h ? dd : 0.f); }
          } else {
              const int kk = (k8 - 64) * 8, dir = kk >> 7, p0 = (kk & 127) >> 1, e = dir == 0 ? j + 1 : 32 - j;
#pragma unroll
              for (int q = 0; q < 4; ++q) { const int pp = p0 + q; const size_t ci = (((size_t)(l * 2 + dir) * 32 + g) * 16 + h) * 64 + pp;
                  const float cr = p.in[19][ci], cim = p.in[20][ci]; const f32x2 lm = gl[((size_t)(lg * 2 + dir) * 64 + pp) * 33 + e];
                  v[2 * q] = cr * lm.x - cim * lm.y; v[2 * q + 1] = -(cr * lm.y + cim * lm.x); }
          }
          u32x4 o; o.x = cvt_pk_bf16(v[0], v[1]); o.y = cvt_pk_bf16(v[2], v[3]); o.z = cvt_pk_bf16(v[4], v[5]); o.w = cvt_pk_bf16(v[6], v[7]);
          *(u32x4*)(YM + it * 8) = o; } }
    { const float* MOD = (const float*)(p.ws + WS_MOD); const float* pe = (const float*)(p.ws + WS_PE); bf16_t* H = (bf16_t*)(p.ws + WS_H);
      const int gw = w * 8 + (t >> 6), NW = G * 8, RL = NLAT / NW, RC = NCTX / NW;
      f32x4 Av[4], Bv[4], Cv[4];
      { const int r0 = gw * RL, b = r0 >> 11; const float* mb = MOD + (size_t)b * 6144;
        row_vecs(Av, Bv, Cv, nullptr, nullptr, p.in[6], mb, mb + 1024, lane);
        rows_run<true, false, false, true>(p.in[0] + (size_t)r0 * D, pe, r0 & 2047, nullptr, nullptr, H + (size_t)r0 * D, RL, Av, Bv, Cv, lane); }
      { const int rc = gw * RC; const float* mb = MOD + (size_t)32 * 6144;
        row_vecs(Av, Bv, Cv, nullptr, nullptr, p.in[6], mb, mb + 1024, lane);
        rows_run<false, false, false, true>(p.in[2] + (size_t)rc * D, nullptr, 0, nullptr, nullptr, H + (size_t)(NLAT + rc) * D, RC, Av, Bv, Cv, lane); }
    }
}

__device__ void phase_post(const Params& p, int l, int which) {
    const int t = tid_l(), lane = t & 63, gw = blockIdx.x * 8 + (t >> 6), NW = gridDim.x * 8, RL = NLAT / NW, RC = NCTX / NW;
    const float* MOD = (const float*)(p.ws + WS_MOD) + (size_t)l * 33 * 6144; bf16_t* H = (bf16_t*)(p.ws + WS_H);
    const float* pe = (const float*)(p.ws + WS_PE);
    const bf16_t* SRC = (const bf16_t*)(p.ws + (which == 0 ? WS_MOUT : WS_F));
    const float* wpost = (which == 0 ? p.in[7] : p.in[9]) + (size_t)l * D;
    const bool hasH = (which == 0) || (l == 0);
    const int ln = l + 1 < 2 ? l + 1 : 1;
    const float* wpre = which == 0 ? p.in[8] + (size_t)l * D : p.in[6] + (size_t)ln * D;
    const float* MODN = which == 0 ? MOD : (const float*)(p.ws + WS_MOD) + (size_t)ln * 33 * 6144;
    const bool first = (l == 0 && which == 0);
    f32x4 Av[4], Bv[4], Cv[4];
    {   const int r0 = gw * RL, b = r0 >> 11; const float* mb = MOD + (size_t)b * 6144; const float* mn = MODN + (size_t)b * 6144;
        row_vecs(Av, Bv, Cv, mb + (which == 0 ? 2048 : 5120), wpost, hasH ? wpre : nullptr, mn + (which == 0 ? 3072 : 0), mn + (which == 0 ? 4096 : 1024), lane);
        float* xo = p.out + (size_t)r0 * D; const bf16_t* sr = SRC + (size_t)r0 * D; bf16_t* ho = H + (size_t)r0 * D;
        if (first) rows_run<true, true, true, true>(p.in[0] + (size_t)r0 * D, pe, r0 & 2047, sr, xo, ho, RL, Av, Bv, Cv, lane);
        else if (hasH) rows_run<false, true, true, true>(xo, nullptr, 0, sr, xo, ho, RL, Av, Bv, Cv, lane);
        else rows_run<false, true, true, false>(xo, nullptr, 0, sr, xo, nullptr, RL, Av, Bv, Cv, lane); }
    if (l == 0) { const int rc = gw * RC; const float* mb = MOD + (size_t)32 * 6144; const float* mn = MODN + (size_t)32 * 6144;
        row_vecs(Av, Bv, Cv, mb + (which == 0 ? 2048 : 5120), wpost, wpre, mn + (which == 0 ? 3072 : 0), mn + (which == 0 ? 4096 : 1024), lane);
        float* xo = (float*)(p.ws + WS_XCTX) + (size_t)rc * D; const bf16_t* sr = SRC + (size_t)(NLAT + rc) * D; bf16_t* ho = H + (size_t)(NLAT + rc) * D;
        if (first) rows_run<false, true, true, true>(p.in[2] + (size_t)rc * D, nullptr, 0, sr, xo, ho, RC, Av, Bv, Cv, lane);
        else rows_run<false, true, true, true>(xo, nullptr, 0, sr, xo, ho, RC, Av, Bv, Cv, lane); }
}

__device__ void sgu_items(const Params& p, int l, LAS unsigned char* lds) {
    const int t = tid_l(), lane = t & 63, wv = t >> 6, fr = lane & 15, fq = lane >> 4;
    const bf16_t* Z = (const bf16_t*)(p.ws + WS_Z); bf16_t* CAT = (bf16_t*)(p.ws + WS_CAT);
    const bf16_t* SW = (const bf16_t*)(p.ws + WS_SGUW) + (size_t)l * 4 * 128 * 128; const float* sb = p.in[13] + (size_t)l * 4 * 128;
    LAS bf16_t* Vt = (LAS bf16_t*)lds;
    const int nitems = ((l == 0) ? MTOT : NLAT) / 128 * 4;
    for (int it = blockIdx.x; it < nitems; it += gridDim.x) {
        const int ck = it >> 2, h = it & 3;
        {
            const int q = t >> 2, part = t & 3; const bf16_t* vp = Z + (size_t)(ck * 128 + q) * DIN + 256 + 64 * h + part * 16;
            const u32x4 w0 = *(const u32x4*)vp, w1 = *(const u32x4*)(vp + 8);
            float v[16] = {bf_lo(w0.x), bf_hi(w0.x), bf_lo(w0.y), bf_hi(w0.y), bf_lo(w0.z), bf_hi(w0.z), bf_lo(w0.w), bf_hi(w0.w), bf_lo(w1.x), bf_hi(w1.x), bf_lo(w1.y), bf_hi(w1.y), bf_lo(w1.z), bf_hi(w1.z), bf_lo(w1.w), bf_hi(w1.w)};
            float s = 0.f;
#pragma unroll
            for (int i = 0; i < 16; ++i) s += v[i];
            s += __shfl_xor(s, 1); s += __shfl_xor(s, 2); const float mu = s * (1.0f / 64.0f); float q2 = 0.f;
#pragma unroll
            for (int i = 0; i < 16; ++i) { v[i] -= mu; q2 += v[i] * v[i]; }
            q2 += __shfl_xor(q2, 1); q2 += __shfl_xor(q2, 2); const float rstd = rsqrtf(q2 * (1.0f / 64.0f) + EPS);
#pragma unroll
            for (int i = 0; i < 16; ++i) Vt[(part * 16 + i) * 136 + q] = (bf16_t)(cvt_pk_bf16(v[i] * rstd, 0.f) & 0xffffu);
        }
        __syncthreads();
        f32x4 acc[4];
#pragma unroll
        for (int dt = 0; dt < 4; ++dt) acc[dt] = (f32x4){0.f, 0.f, 0.f, 0.f};
        const int p0 = 16 * wv;
#pragma unroll
        for (int kq = 0; kq < 4; ++kq) {
            const bf16x8 wf = *(const bf16x8*)(SW + ((size_t)h * 128 + p0 + fr) * 128 + kq * 32 + fq * 8);
#pragma unroll
            for (int dt = 0; dt < 4; ++dt) { const bf16x8 vf = *(const LAS bf16x8*)(Vt + (16 * dt + fr) * 136 + kq * 32 + fq * 8); acc[dt] = __builtin_amdgcn_mfma_f32_16x16x32_bf16(vf, wf, acc[dt], 0, 0, 0); }
        }
        {
            const int pt = p0 + fr; const float bias = sb[h * 128 + pt]; const size_t row = (size_t)ck * 128 + pt;
#pragma unroll
            for (int dt = 0; dt < 4; ++dt) { const int dcol = 64 * h + 16 * dt + 4 * fq; const u32x2 uw = *(const u32x2*)(Z + row * DIN + dcol);
                const float o0 = bf_lo(uw.x) * (acc[dt][0] + bias), o1 = bf_hi(uw.x) * (acc[dt][1] + bias), o2 = bf_lo(uw.y) * (acc[dt][2] + bias), o3 = bf_hi(uw.y) * (acc[dt][3] + bias);
                *(u32x2*)(CAT + row * D + dcol) = (u32x2){cvt_pk_bf16(o0, o1), cvt_pk_bf16(o2, o3)}; }
        }
        __syncthreads();
    }
}

__device__ void pool_items(const Params& p, int l, LAS unsigned char* lds) {
    const int t = tid_l(), lane = t & 63, wv = t >> 6, fr = lane & 15, fq = lane >> 4;
    const bf16_t* Z = (const bf16_t*)(p.ws + WS_Z); bf16_t* CAT = (bf16_t*)(p.ws + WS_CAT);
    const bf16_t* PW = (const bf16_t*)(p.ws + WS_POOLWT) + (size_t)l * 4 * 64 * 64; const float* psc = p.in[25] + (size_t)l * 256;
    LAS bf16_t* Pl = (LAS bf16_t*)lds;
    LAS bf16_t* Dl = Pl + 256 * 72;
    const int nitems = ((l == 0) ? MTOT : NLAT) / 256 * 4;
    for (int it = blockIdx.x; it < nitems; it += gridDim.x) {
        const int pt = it >> 2, i = it & 3, wdw = 2 << i;
        const int row = t >> 1, half = t & 1;
        { const bf16_t* src = Z + (size_t)(pt * 256 + row) * DIN + 1024 + 64 * i + half * 32;
#pragma unroll
          for (int q = 0; q < 4; ++q) *(LAS u32x4*)(Pl + row * 72 + half * 32 + q * 8) = *(const u32x4*)(src + q * 8); }
        __syncthreads();
        { const int seg = pt < 256 ? 64 : 256, pos = row & (seg - 1), sb = row - pos;
          int lo = pos - wdw / 2; int hi = lo + wdw; lo = lo < 0 ? 0 : lo; hi = hi > seg ? seg : hi; const float inv = 1.0f / (float)(hi - lo);
#pragma unroll
          for (int q = 0; q < 4; ++q) {
              float s[8];
#pragma unroll
              for (int e = 0; e < 8; ++e) s[e] = 0.f;
              for (int tau = lo; tau < hi; ++tau) { const u32x4 w = *(const LAS u32x4*)(Pl + (sb + tau) * 72 + half * 32 + q * 8);
                  s[0] += bf_lo(w.x); s[1] += bf_hi(w.x); s[2] += bf_lo(w.y); s[3] += bf_hi(w.y); s[4] += bf_lo(w.z); s[5] += bf_hi(w.z); s[6] += bf_lo(w.w); s[7] += bf_hi(w.w); }
              const u32x4 w = *(const LAS u32x4*)(Pl + row * 72 + half * 32 + q * 8);
              const float c[8] = {bf_lo(w.x), bf_hi(w.x), bf_lo(w.y), bf_hi(w.y), bf_lo(w.z), bf_hi(w.z), bf_lo(w.w), bf_hi(w.w)};
              u32x4 o; o.x = cvt_pk_bf16(s[0] * inv - c[0], s[1] * inv - c[1]); o.y = cvt_pk_bf16(s[2] * inv - c[2], s[3] * inv - c[3]);
              o.z = cvt_pk_bf16(s[4] * inv - c[4], s[5] * inv - c[5]); o.w = cvt_pk_bf16(s[6] * inv - c[6], s[7] * inv - c[7]);
              *(LAS u32x4*)(Dl + row * 72 + half * 32 + q * 8) = o; } }
        __syncthreads();
        f32x4 acc[2][4];
#pragma unroll
        for (int a = 0; a < 2; ++a)
#pragma unroll
            for (int o = 0; o < 4; ++o) acc[a][o] = (f32x4){0.f, 0.f, 0.f, 0.f};
#pragma unroll
        for (int kc = 0; kc < 2; ++kc) {
            bf16x8 df[2];
#pragma unroll
            for (int a = 0; a < 2; ++a) df[a] = *(const LAS bf16x8*)(Dl + (32 * wv + 16 * a + fr) * 72 + kc * 32 + fq * 8);
#pragma unroll
            for (int o = 0; o < 4; ++o) { const bf16x8 wf = *(const bf16x8*)(PW + ((size_t)i * 64 + 16 * o + fr) * 64 + kc * 32 + fq * 8);
#pragma unroll
                for (int a = 0; a < 2; ++a) acc[a][o] = __builtin_amdgcn_mfma_f32_16x16x32_bf16(wf, df[a], acc[a][o], 0, 0, 0); }
        }
#pragma unroll
        for (int a = 0; a < 2; ++a) { const size_t r = (size_t)pt * 256 + 32 * wv + 16 * a + fr;
#pragma unroll
            for (int o = 0; o < 4; ++o) { const int oc = 64 * i + 16 * o + 4 * fq; const f32x4 sc = *(const f32x4*)(psc + oc); const f32x4 v = acc[a][o] * sc;
                *(u32x2*)(CAT + r * D + 768 + oc) = (u32x2){cvt_pk_bf16(v[0], v[1]), cvt_pk_bf16(v[2], v[3])}; } }
        __syncthreads();
    }
}

__device__ void phase_scan(const Params& p, int l) {
    const size_t gt = (size_t)blockIdx.x * 512 + tid_l(), GT = (size_t)gridDim.x * 512;
    const float* S = (const float*)(p.ws + WS_S); bf16_t* U = (bf16_t*)(p.ws + WS_USSM); const f32x2* gl = (const f32x2*)(p.ws + WS_LAMP);
    for (size_t id = gt; id < (size_t)NB * 32 * 128; id += GT) {
        const int dp = (int)(id & 127), dir = dp >> 6, pp = dp & 63, g = (int)((id >> 7) & 31), b = (int)(id >> 12);
        const f32x2 lt = gl[((size_t)((l * 32 + g) * 2 + dir) * 64 + pp) * 33 + 32];
        float hr = 0.f, hi = 0.f;
        for (int st = 0; st < 72; ++st) {
            int bc;
            if (st < 8) bc = 2048 + 8 * b + (dir == 0 ? st : 7 - st);
            else bc = 64 * b + (dir == 0 ? st - 8 : 71 - st);
            const size_t rowi = (size_t)g * NBC + bc;
            const f32x2 sv = *(const f32x2*)(S + rowi * 256 + dir * 128 + 2 * pp);
            *(unsigned*)(U + rowi * KY + 512 + dir * 128 + 2 * pp) = cvt_pk_bf16(hr, hi);
            const float nr = lt.x * hr - lt.y * hi + sv.x, ni = lt.x * hi + lt.y * hr + sv.y;
            hr = nr; hi = ni;
        }
    }
}

#define XB_TMO      128
#define XB_XCNT(j)  (256  + 64 * (j))
#define XB_XSUB(j)  (1280 + 64 * (j))
#define XB_XGEN(j)  (2304 + 64 * (j))
#define XB_TOP      3328
#define XB_TOPGEN   3392
#define XCD_BAR_WORDS 3456
#define XB_SPIN_CAP (1u << 22)
__device__ __forceinline__ unsigned xb_ld(unsigned* p)              { return __hip_atomic_load(p, __ATOMIC_RELAXED, __HIP_MEMORY_SCOPE_AGENT); }
__device__ __forceinline__ unsigned xb_add(unsigned* p, unsigned v) { return __hip_atomic_fetch_add(p, v, __ATOMIC_RELAXED, __HIP_MEMORY_SCOPE_AGENT); }
__device__ __forceinline__ unsigned xb_xcc_id() { return (unsigned)__builtin_amdgcn_s_getreg((3 << 11) | 20) & 0xFu; }
#define XB_SPIN(cond, bar) do { unsigned _sp = 0; while (cond) { __builtin_amdgcn_s_sleep(1); \
    if ((++_sp & 255u) == 0u) { if (xb_ld(&(bar)[XB_TMO])) break; if (_sp > XB_SPIN_CAP) { atomicAdd(&(bar)[XB_TMO], 1u); break; } } } } while (0)
struct XcdBarrier { unsigned* bar; unsigned x; volatile LAS unsigned* st; };
__device__ __forceinline__ XcdBarrier xcd_barrier_post(unsigned* bar, volatile LAS unsigned* st) {
    XcdBarrier b; b.bar = bar; b.x = xb_xcc_id(); b.st = st;
    if (threadIdx.x == 0) (void)xb_add(&bar[XB_XCNT(b.x)], 1u);
    return b;
}
__device__ __forceinline__ void xcd_barrier_complete(unsigned* bar, unsigned x, unsigned& nloc, unsigned& nx) {
    const unsigned G = gridDim.x * gridDim.y * gridDim.z;
    unsigned sum, cnt, mine, sp = 0u;
    for (;;) {
        sum = 0u; cnt = 0u; mine = 0u;
#pragma unroll
        for (unsigned j = 0; j < 16; ++j) { const unsigned c = xb_ld(&bar[XB_XCNT(j)]); sum += c; cnt += (c > 0u) ? 1u : 0u; mine = (j == x) ? c : mine; }
        if (sum == G) break;
        __builtin_amdgcn_s_sleep(1);
        if ((++sp & 255u) == 0u) { if (xb_ld(&bar[XB_TMO])) break; if (sp > XB_SPIN_CAP) { atomicAdd(&bar[XB_TMO], 1u); break; } }
    }
    nloc = mine > 0u ? mine : 1u; nx = cnt > 0u ? cnt : 1u;
}
__device__ __forceinline__ void xcd_barrier(const XcdBarrier& b) {
    asm volatile("s_waitcnt vmcnt(0)" ::: "memory");
    __syncthreads();
    if (threadIdx.x == 0) {
        unsigned* bar = b.bar;
        __builtin_amdgcn_s_waitcnt(0);
        unsigned nloc = b.st[0], nx = b.st[1];
        if (nloc == 0u) { xcd_barrier_complete(bar, b.x, nloc, nx); b.st[0] = nloc; b.st[1] = nx; }
        const unsigned old = xb_add(&bar[XB_XSUB(b.x)], 1u);
        const unsigned gen = old / nloc;
        if (old + 1u == (gen + 1u) * nloc) {
            __builtin_amdgcn_fence(__ATOMIC_RELEASE, "agent");
            asm volatile("s_waitcnt vmcnt(0)" ::: "memory");
            const unsigned og = xb_add(&bar[XB_TOP], 1u);
            const unsigned tg = og / nx;
            if (og + 1u == (tg + 1u) * nx) xb_add(&bar[XB_TOPGEN], 1u);
            else XB_SPIN(xb_ld(&bar[XB_TOPGEN]) == tg, bar);
            __builtin_amdgcn_fence(__ATOMIC_ACQUIRE, "agent");
            xb_add(&bar[XB_XGEN(b.x)], 1u);
            asm volatile("s_waitcnt vmcnt(0)" ::: "memory");
        } else {
            XB_SPIN(xb_ld(&bar[XB_XGEN(b.x)]) == gen, bar);
            __builtin_amdgcn_fence(__ATOMIC_ACQUIRE, "agent");
            asm volatile("s_waitcnt vmcnt(0)" ::: "memory");
        }
    }
    __syncthreads();
}

__global__ void __launch_bounds__(512, 2) fwd_kernel(Params p) {
    extern __shared__ __attribute__((aligned(16))) unsigned char shm[];
    LAS unsigned char* lds = (LAS unsigned char*)shm;
    volatile LAS unsigned* xst = (volatile LAS unsigned*)(lds + LDS_BYTES - 16);
    XcdBarrier xb; xb.bar = (unsigned*)(p.ws + WS_BAR); xb.x = 0; xb.st = xst;
    if (p.sync) { if (threadIdx.x == 0) { xst[0] = 0u; xst[1] = 0u; xst[2] = 0u; xst[3] = 0u; } __syncthreads(); xb = xcd_barrier_post((unsigned*)(p.ws + WS_BAR), xst); }
    for (int ph = p.ph_lo; ph < p.ph_hi; ++ph) {
        unsigned char* ws = p.ws; asm volatile("" : "+s"(ws));
        if (ph == 0) phase_p0(p, lds);
        else if (ph == 1) phase_p1(p);
        else {
            const int l = (ph - 2) / 10, s = (ph - 2) % 10;
            const int nMall = (l == 0) ? MTOT / 256 : NLAT / 256;
            Sched S;
            if (s == 0) {
                GemmP g{(const bf16_t*)(ws + WS_H), (const bf16_t*)(ws + WS_WINT) + (size_t)l * DIN * D, D, D, D, 0, 0};
                if (l == 0) S.init(MTOT / 256, 5, 1, 0, 0, 0, 0); else S.init(NLAT / 256, 5, 1, NCTX / 256, 2, NLAT / 256, 2);
                EpiWin E{(bf16_t*)(ws + WS_Z), (bf16_t*)(ws + WS_USSM)};
                for (int rep = 0; rep < GEMM_REP; ++rep) gemm_phase(lds, g, S, E);
            } else if (s == 1) {
                GemmP g{(const bf16_t*)(ws + WS_USSM), (const bf16_t*)(ws + WS_SMAT) + (size_t)l * 32 * 256 * KS, KY, KS, KS, (size_t)NBC * KY, (size_t)256 * KS};
                S.init(NBC / 256, 1, 32, 0, 0, 0, 0);
                EpiS E{(float*)(ws + WS_S)};
                for (int rep = 0; rep < GEMM_REP; ++rep) gemm_phase(lds, g, S, E);
                __syncthreads();
                for (int rep = 0; rep < MIX_REP; ++rep) { sgu_items(p, l, lds); pool_items(p, l, lds); }
            } else if (s == 2) {
                for (int rep = 0; rep < MIX_REP; ++rep) phase_scan(p, l);
            } else if (s == 3) {
                GemmP g{(const bf16_t*)(ws + WS_USSM), (const bf16_t*)(ws + WS_YMAT) + (size_t)l * 32 * 512 * KY, KY, KY, KY, (size_t)NBC * KY, (size_t)512 * KY};
                S.init(l == 0 ? NBC / 256 : NLAT / TCH / 256, 2, 32, 0, 0, 0, 0);
                EpiY E{(bf16_t*)(ws + WS_Z)};
                for (int rep = 0; rep < GEMM_REP; ++rep) gemm_phase(lds, g, S, E);
            } else if (s == 4) {
                GemmP g{(const bf16_t*)(ws + WS_Z) + 512, (const bf16_t*)(ws + WS_GLUT) + (size_t)l * 512 * 512, DIN, 512, 512, 0, 0};
                S.init(nMall, 2, 1, 0, 0, 0, 0);
                EpiGlu E{(const bf16_t*)(ws + WS_Z), (bf16_t*)(ws + WS_CAT), p.in[23] + (size_t)l * 512};
                for (int rep = 0; rep < GEMM_REP; ++rep) gemm_phase(lds, g, S, E);
            } else if (s == 5) {
                GemmP g{(const bf16_t*)(ws + WS_CAT), (const bf16_t*)(ws + WS_WOUTT) + (size_t)l * D * D, D, D, D, 0, 0};
                S.init(nMall, 4, 1, 0, 0, 0, 0);
                EpiBf E{(bf16_t*)(ws + WS_MOUT), D};
                for (int rep = 0; rep < GEMM_REP; ++rep) gemm_phase(lds, g, S, E);
            } else if (s == 6) {
                phase_post(p, l, 0);
            } else if (s == 7) {
                GemmP g{(const bf16_t*)(ws + WS_H), (const bf16_t*)(ws + WS_WGUT) + (size_t)l * 2 * DFF * D, D, D, D, 0, 0};
                S.init(nMall, 22, 1, 0, 0, 0, 0);
                EpiGU E{(bf16_t*)(ws + WS_HID)};
                for (int rep = 0; rep < GEMM_REP; ++rep) gemm_phase(lds, g, S, E);
            } else if (s == 8) {
                GemmP g{(const bf16_t*)(ws + WS_HID), (const bf16_t*)(ws + WS_WDT) + (size_t)l * D * DFF, DFF, DFF, DFF, 0, 0};
                S.init(nMall, 4, 1, 0, 0, 0, 0);
                EpiBf E{(bf16_t*)(ws + WS_F), D};
                for (int rep = 0; rep < GEMM_REP; ++rep) gemm_phase(lds, g, S, E);
            } else {
                phase_post(p, l, 1);
            }
        }
        if (p.sync && ph + 1 < p.ph_hi) { if (ph == 0) cg::this_grid().sync(); else xcd_barrier(xb); }
    }
}

extern "C" void kernel_launch(void* const* d_in, const int* in_sizes, int n_in, void* d_out, int out_size, void* d_ws, size_t ws_size, hipStream_t stream) {
    static int grid = 0;
    if (grid == 0) {
        if (n_in != 29 || ws_size < WS_END) { fprintf(stderr, "kernel_launch: bad n_in %d or ws %zu < %zu\n", n_in, ws_size, (size_t)WS_END); grid = -1; return; }
        int dev = 0, cus = 0, per_cu = 0;
        hipGetDevice(&dev); hipDeviceGetAttribute(&cus, hipDeviceAttributeMultiprocessorCount, dev);
        if (hipFuncSetAttribute((const void*)fwd_kernel, hipFuncAttributeMaxDynamicSharedMemorySize, LDS_BYTES) != hipSuccess) { fprintf(stderr, "hipFuncSetAttribute failed\n"); grid = -1; return; }
        if (hipOccupancyMaxActiveBlocksPerMultiprocessor(&per_cu, (const void*)fwd_kernel, 512, LDS_BYTES) != hipSuccess || per_cu < 1) per_cu = 1;
        (void)hipGetLastError();
        grid = cus * 1;
    }
    if (grid < 0) return;
    Params p{};
    for (int i = 0; i < 29; ++i) p.in[i] = (const float*)d_in[i];
    p.out = (float*)d_out; p.ws = (unsigned char*)d_ws;
#if ONE_LAUNCH
    if (hipMemsetAsync((char*)d_ws + WS_BAR, 0, XCD_BAR_WORDS * 4, stream) != hipSuccess) { fprintf(stderr, "memset failed\n"); return; }
    p.ph_lo = 0; p.ph_hi = NPH; p.sync = 1;
    void* args[] = {&p};
    hipError_t e = hipLaunchCooperativeKernel((const void*)fwd_kernel, dim3(grid), dim3(512), args, LDS_BYTES, stream);
    if (e != hipSuccess) fprintf(stderr, "cooperative launch failed: %s (grid %d)\n", hipGetErrorString(e), grid);
#else
    for (int ph = 0; ph < NPH; ++ph) {
        p.ph_lo = ph; p.ph_hi = ph + 1; p.sync = 0;
        hipLaunchKernelGGL(fwd_kernel, dim3(grid), dim3(512), LDS_BYTES, stream, p);
    }
#endif
}
```

```cpp
#include <hip/hip_runtime.h>
#include <hip/hip_cooperative_groups.h>
#include <cstdio>
#include <cstdint>
namespace cg = cooperative_groups;

#ifndef GEMM_REP
#define GEMM_REP 1
#endif
#ifndef MIX_REP
#define MIX_REP 1
#endif
#ifndef ONE_LAUNCH
#define ONE_LAUNCH 1
#endif

#define LAS __attribute__((address_space(3)))
typedef unsigned short bf16_t;
typedef short bf16x8 __attribute__((ext_vector_type(8)));
typedef float f32x4 __attribute__((ext_vector_type(4)));
typedef float f32x2 __attribute__((ext_vector_type(2)));
typedef unsigned u32x4 __attribute__((ext_vector_type(4)));
typedef unsigned u32x2 __attribute__((ext_vector_type(2)));

constexpr int D = 1024, NB = 32, SEQ = 2048, CTXL = 256, NLAT = NB * SEQ, NCTX = NB * CTXL, MTOT = NLAT + NCTX;
constexpr int DIN = 1280, DFF = 2816, TCH = 32  , NBC = MTOT / TCH  , KY = 768, KS = 512;
constexpr int NPH = 22;
constexpr int LDS_BYTES = 147456;
constexpr float EPS = 1e-6f;

constexpr size_t al256(size_t x) { return (x + 255) & ~(size_t)255; }
constexpr size_t WS_WINT = 0;
constexpr size_t WS_WOUTT = WS_WINT + al256((size_t)2 * DIN * D * 2);
constexpr size_t WS_GLUT = WS_WOUTT + al256((size_t)2 * D * D * 2);
constexpr size_t WS_WGUT = WS_GLUT + al256((size_t)2 * 512 * 512 * 2);
constexpr size_t WS_WDT = WS_WGUT + al256((size_t)2 * 2 * DFF * D * 2);
constexpr size_t WS_SGUW = WS_WDT + al256((size_t)2 * D * DFF * 2);
constexpr size_t WS_POOLWT = WS_SGUW + al256((size_t)2 * 4 * 128 * 128 * 2);
constexpr size_t WS_MOD = WS_POOLWT + al256((size_t)2 * 4 * 64 * 64 * 2);
constexpr size_t WS_PE = WS_MOD + al256((size_t)2 * 33 * 6144 * 4);
constexpr size_t WS_KT = WS_PE + al256((size_t)96 * 512 * 4);
constexpr size_t WS_LAMP = WS_KT + al256((size_t)2 * 32 * 2 * 32 * 256 * 4);
constexpr size_t WS_BBAR = WS_LAMP + al256((size_t)2 * 32 * 2 * 64 * 33 * 8);
constexpr size_t WS_SMAT = WS_BBAR + al256((size_t)2 * 32 * 2 * 64 * 16 * 8);
constexpr size_t WS_YMAT = WS_SMAT + al256((size_t)2 * 32 * 256 * 512 * 2);
constexpr size_t WS_XCTX = WS_YMAT + al256((size_t)2 * 32 * 512 * 768 * 2);
constexpr size_t WS_H = WS_XCTX + al256((size_t)NCTX * D * 4);
constexpr size_t WS_R = WS_H + al256((size_t)MTOT * D * 2);
constexpr size_t WS_Z = WS_R;
constexpr size_t WS_CAT = WS_Z + al256((size_t)MTOT * DIN * 2);
constexpr size_t WS_MOUT = WS_CAT + al256((size_t)MTOT * D * 2);
constexpr size_t WS_REND = WS_MOUT + al256((size_t)MTOT * D * 2);
constexpr size_t WS_HID = WS_R;
constexpr size_t WS_S = WS_MOUT;
constexpr size_t WS_USSM = WS_REND;
constexpr size_t WS_F = WS_USSM;
constexpr size_t WS_BAR = WS_USSM + al256((size_t)MTOT * D * 2);
constexpr size_t WS_END = WS_BAR + 16384;
static_assert((size_t)MTOT * DFF * 2 <= WS_REND - WS_R, "HID alias");
static_assert((size_t)32 * NBC * 256 * 4 <= (size_t)MTOT * D * 2, "S alias");
static_assert((size_t)32 * NBC * KY * 2 <= (size_t)MTOT * D * 2, "USSM alias");

struct Params {
    const float* in[29];
    float* out;
    unsigned char* ws;
    int ph_lo, ph_hi, sync, pad;
};

__device__ __forceinline__ unsigned cvt_pk_bf16(float lo, float hi) { unsigned r; asm volatile("v_cvt_pk_bf16_f32 %0, %1, %2" : "=v"(r) : "v"(lo), "v"(hi)); return r; }
__device__ __forceinline__ float bf_lo(unsigned w) { return __uint_as_float(w << 16); }
__device__ __forceinline__ float bf_hi(unsigned w) { return __uint_as_float(w & 0xffff0000u); }
__device__ __forceinline__ float gelu_t(float x) { const float x2 = x * x, pz = fmaf(-0.10294324f, x2, -2.3022082f); return x * __builtin_amdgcn_rcpf(1.0f + __builtin_amdgcn_exp2f(x * pz)); }
__device__ __forceinline__ float silu_f(float x) { return x * __builtin_amdgcn_rcpf(1.0f + __builtin_amdgcn_exp2f(-1.4426950408889634f * x)); }
__device__ __forceinline__ float sigmoid_f(float x) { return __builtin_amdgcn_rcpf(1.0f + __builtin_amdgcn_exp2f(-1.4426950408889634f * x)); }
__device__ __forceinline__ int tid_l() { int t = threadIdx.x; asm volatile("" : "+v"(t)); return t; }
__device__ __forceinline__ float wave_sum(float v) {
#pragma unroll
    for (int o = 1; o < 64; o <<= 1) v += __shfl_xor(v, o);
    return v;
}

constexpr int BM = 256, BK = 64, HALF = 128, HTB = HALF * BK * 2, NXCD = 8, WGM = 8;
__host__ __device__ __forceinline__ int lds_byte(int r, int c) { const int st = (r >> 4) * 2 + (c >> 5), rr = r & 15, cc = c & 31, ob = rr * 64 + cc * 2; return st * 1024 + (ob ^ (((ob >> 9) & 1) << 5)); }
__host__ __device__ __forceinline__ void stage_rc(int b, int& R, int& C) { const int st = b / 1024, sb = b % 1024, swz = sb ^ (((sb >> 9) & 1) << 5); R = (st >> 1) * 16 + swz / 64; C = (st & 1) * 32 + (swz % 64) / 2; }
__host__ __device__ __forceinline__ int perm32(int rho) { const int n = rho >> 4, i = rho & 15; return 8 * (i >> 2) + 4 * n + (i & 3); }

struct Unit { int pm, pn, g; };
struct GemmP { const bf16_t* A; const bf16_t* Bt; int lda, ldb, K; size_t gsA, gsB; };

struct Sched {
    int nM, nN, n1, nM2, nN2, pm2, pn2, total, G, c;
    __device__ void init(int nM_, int nN_, int nG_, int nM2_, int nN2_, int pm2_, int pn2_) {
        nM = nM_; nN = nN_; n1 = nM_ * nN_ * nG_; nM2 = nM2_; nN2 = nN2_; pm2 = pm2_; pn2 = pn2_; total = n1 + nM2_ * nN2_; G = (int)gridDim.x; c = (int)blockIdx.x;
    }
    __device__ __forceinline__ static void dec(int w, int nM_, int nN_, int& pm, int& pn) {
        const int nig = WGM * nN_, gid = w / nig, fm = gid * WGM, gsz = (nM_ - fm) < WGM ? (nM_ - fm) : WGM;
        pm = fm + ((w % nig) % gsz); pn = (w % nig) / gsz;
    }
    __device__ bool next(int i, Unit& u) const {
        const long L = (long)i * G + c; if (L >= total) return false;
        int w = (int)L; { const int q = total / NXCD, r = total % NXCD, xcd = w % NXCD, off = w / NXCD; w = (xcd < r ? xcd * (q + 1) : r * (q + 1) + (xcd - r) * q) + off; }
        if (w < n1) { const int per = nM * nN; u.g = w / per; dec(w % per, nM, nN, u.pm, u.pn); }
        else { u.g = 0; dec(w - n1, nM2, nN2, u.pm, u.pn); u.pm += pm2; u.pn += pn2; }
        return true;
    }
};

template <class Epi>
__device__ __forceinline__ void gemm_phase(LAS unsigned char* lds, const GemmP g, const Sched& S, const Epi& E) {
    const int tid = tid_l(), wid = __builtin_amdgcn_readfirstlane(tid >> 6), lane = tid & 63, wr = wid >> 2, wc = wid & 3, fr = lane & 15, fq = lane >> 4;
    const int nt = g.K / BK;
    unsigned voffA[2], voffB[2];
#pragma unroll
    for (int i = 0; i < 2; ++i) { int R, C; stage_rc(tid * 16 + i * 8192, R, C); const int Rb = (R & ~31) + perm32(R & 31);
        voffA[i] = (unsigned)(R * g.lda + C) * 2u; voffB[i] = (unsigned)(Rb * g.ldb + C) * 2u; }
    const size_t kstep = (size_t)(BK * 2);
    const size_t hstepA = (size_t)HALF * g.lda * 2, hstepB = (size_t)HALF * g.ldb * 2;
    const size_t tstepA = 2 * hstepA, tstepB = 2 * hstepB;
    const unsigned ldsw = (unsigned)wid * 1024u;
    const int aoff = lds_byte(wr * 64 + fr, fq * 8), boff = lds_byte(wc * 32 + fr, fq * 8);
#define PG8_SA(b, h) (((b) * 2 + (h)) * HTB)
#define PG8_SB(b, h) ((4 + (b) * 2 + (h)) * HTB)
#define PG8_STAGE(bufoff, gbase, voff) do { _Pragma("unroll") for (int _i = 0; _i < 2; ++_i) \
        __builtin_amdgcn_global_load_lds((const unsigned*)((const char*)(gbase) + (voff)[_i]), (LAS unsigned*)(lds + (bufoff) + ldsw + _i * 8192), 16, 0, 0); } while (0)
#define PG8_LDA(dst, b, h) do { _Pragma("unroll") for (int m = 0; m < 4; ++m) _Pragma("unroll") for (int k = 0; k < 2; ++k) dst[m][k] = *(const LAS bf16x8*)(lds + PG8_SA(b, h) + aoff + m * 2048 + k * 1024); } while (0)
#define PG8_LDB(dst, b, h) do { _Pragma("unroll") for (int n = 0; n < 2; ++n) _Pragma("unroll") for (int k = 0; k < 2; ++k) dst[n][k] = *(const LAS bf16x8*)(lds + PG8_SB(b, h) + boff + n * 2048 + k * 1024); } while (0)
#define PG8_MMA(ai, bj, At, Bt) do { __builtin_amdgcn_s_setprio(1); _Pragma("unroll") for (int m = 0; m < 4; ++m) _Pragma("unroll") for (int n = 0; n < 2; ++n) _Pragma("unroll") for (int k = 0; k < 2; ++k) \
        acc[ai][bj][m][n] = __builtin_amdgcn_mfma_f32_16x16x32_bf16(Bt[n][k], At[m][k], acc[ai][bj][m][n], 0, 0, 0); __builtin_amdgcn_s_setprio(0); } while (0)
#define PG8_WAIT_V(n) asm volatile("s_waitcnt vmcnt(" #n ")" ::: "memory")
#define PG8_WAIT_L(n) asm volatile("s_waitcnt lgkmcnt(" #n ")" ::: "memory")
#define PG8_BAR __builtin_amdgcn_s_barrier()
#define PG8_SCHED __builtin_amdgcn_sched_barrier(0)
    Unit cur, nxt; int ui = 0;
    if (!S.next(0, cur)) return;
    f32x4 acc[2][2][4][2];
#pragma unroll
    for (int a = 0; a < 2; ++a)
#pragma unroll
        for (int b = 0; b < 2; ++b)
#pragma unroll
            for (int m = 0; m < 4; ++m)
#pragma unroll
                for (int n = 0; n < 2; ++n) acc[a][b][m][n] = (f32x4){0.f, 0.f, 0.f, 0.f};
    bf16x8 At[4][2], B0[2][2], B1[2][2];
    const char* cA = (const char*)g.A + (size_t)cur.g * g.gsA * 2 + (size_t)cur.pm * tstepA;
    const char* cB = (const char*)g.Bt + (size_t)cur.g * g.gsB * 2 + (size_t)cur.pn * tstepB;
    PG8_STAGE(PG8_SB(0, 0), cB, voffB); PG8_STAGE(PG8_SB(0, 1), cB + hstepB, voffB); PG8_STAGE(PG8_SA(0, 0), cA, voffA); PG8_STAGE(PG8_SA(0, 1), cA + hstepA, voffA);
    if (wr == 1) PG8_BAR;
    PG8_WAIT_V(2); PG8_BAR;
    PG8_STAGE(PG8_SB(1, 0), cB + kstep, voffB); PG8_STAGE(PG8_SA(1, 0), cA + kstep, voffA); PG8_STAGE(PG8_SB(1, 1), cB + hstepB + kstep, voffB);
    PG8_WAIT_V(6); PG8_BAR;
    for (;;) {
        const bool has_next = S.next(ui + 1, nxt);
        const char* nA = has_next ? (const char*)g.A + (size_t)nxt.g * g.gsA * 2 + (size_t)nxt.pm * tstepA : cA;
        const char* nB = has_next ? (const char*)g.Bt + (size_t)nxt.g * g.gsB * 2 + (size_t)nxt.pn * tstepB : cB;
        for (int t = 0; t < nt; t += 2) {
            const bool last = (t == nt - 2);
            const char* a1 = cA + (size_t)(t + 1) * kstep;
            const char* a2 = last ? nA : cA + (size_t)(t + 2) * kstep; const char* b2 = last ? nB : cB + (size_t)(t + 2) * kstep;
            const char* a3 = a2 + kstep; const char* b3 = b2 + kstep;
            PG8_LDB(B0, 0, 0); PG8_LDB(B1, 0, 1); PG8_SCHED; PG8_LDA(At, 0, 0); PG8_STAGE(PG8_SA(1, 1), a1 + hstepA, voffA);
            PG8_WAIT_V(8); PG8_WAIT_L(0); PG8_BAR; PG8_MMA(0, 0, At, B0); PG8_MMA(0, 1, At, B1); PG8_BAR; PG8_SCHED;
            PG8_LDA(At, 0, 1); PG8_STAGE(PG8_SB(0, 0), b2, voffB); PG8_STAGE(PG8_SB(0, 1), b2 + hstepB, voffB); PG8_STAGE(PG8_SA(0, 0), a2, voffA);
            PG8_WAIT_V(8); PG8_WAIT_L(0); PG8_BAR; PG8_MMA(1, 0, At, B0); PG8_MMA(1, 1, At, B1); PG8_BAR; PG8_SCHED;
            PG8_LDB(B0, 1, 0); PG8_LDB(B1, 1, 1); PG8_SCHED; PG8_LDA(At, 1, 0); PG8_STAGE(PG8_SA(0, 1), a2 + hstepA, voffA);
            PG8_WAIT_V(8); PG8_WAIT_L(0); PG8_BAR; PG8_MMA(0, 0, At, B0); PG8_MMA(0, 1, At, B1); PG8_BAR; PG8_SCHED;
            PG8_LDA(At, 1, 1); PG8_STAGE(PG8_SB(1, 0), b3, voffB); PG8_STAGE(PG8_SB(1, 1), b3 + hstepB, voffB); PG8_STAGE(PG8_SA(1, 0), a3, voffA);
            PG8_WAIT_V(8); PG8_WAIT_L(0); PG8_BAR; PG8_MMA(1, 0, At, B0); PG8_MMA(1, 1, At, B1); PG8_BAR; PG8_SCHED;
        }
        if (wr == 0) PG8_BAR;
        E(acc, cur, wr, wc, fr, fq);
        if (!has_next) break;
#pragma unroll
        for (int a = 0; a < 2; ++a)
#pragma unroll
            for (int b = 0; b < 2; ++b)
#pragma unroll
                for (int m = 0; m < 4; ++m)
#pragma unroll
                    for (int n = 0; n < 2; ++n) acc[a][b][m][n] = (f32x4){0.f, 0.f, 0.f, 0.f};
        cur = nxt; cA = nA; cB = nB; ++ui;
        if (wr == 1) PG8_BAR;
    }
    PG8_WAIT_V(0);
    PG8_BAR;
#undef PG8_SA
#undef PG8_SB
#undef PG8_STAGE
#undef PG8_LDA
#undef PG8_LDB
#undef PG8_MMA
#undef PG8_WAIT_V
#undef PG8_WAIT_L
#undef PG8_BAR
#undef PG8_SCHED
}

__device__ __forceinline__ u32x4 pack8(const f32x4 a, const f32x4 b) { u32x4 w; w.x = cvt_pk_bf16(a[0], a[1]); w.y = cvt_pk_bf16(a[2], a[3]); w.z = cvt_pk_bf16(b[0], b[1]); w.w = cvt_pk_bf16(b[2], b[3]); return w; }

struct EpiWin {
    bf16_t* Z; bf16_t* U;
    __device__ __forceinline__ void operator()(const f32x4 (&acc)[2][2][4][2], const Unit& u, int wr, int wc, int fr, int fq) const {
        const int row0 = u.pm * BM + wr * 64 + fr;
#pragma unroll
        for (int ai = 0; ai < 2; ++ai)
#pragma unroll
            for (int m = 0; m < 4; ++m) {
                const int r = row0 + ai * HALF + m * 16;
#pragma unroll
                for (int bj = 0; bj < 2; ++bj) {
                    const int c0 = u.pn * BM + bj * HALF + wc * 32 + 8 * fq;
                    f32x4 v0 = acc[ai][bj][m][0], v1 = acc[ai][bj][m][1];
                    if (u.pn < 2) {
#pragma unroll
                        for (int j = 0; j < 4; ++j) { v0[j] = gelu_t(v0[j]); v1[j] = gelu_t(v1[j]); }
                        *(u32x4*)(Z + (size_t)r * DIN + c0) = pack8(v0, v1);
                    } else if (u.pn < 4) {
                        const int cc = c0 - 512, gg = cc >> 4, h0 = cc & 15;
                        *(u32x4*)(U + ((size_t)gg * NBC + (r >> 5)) * KY + (r & 31) * 16 + h0) = pack8(v0, v1);
                    } else {
                        *(u32x4*)(Z + (size_t)r * DIN + c0) = pack8(v0, v1);
                    }
                }
            }
    }
};
struct EpiS {
    float* S;
    __device__ __forceinline__ void operator()(const f32x4 (&acc)[2][2][4][2], const Unit& u, int wr, int wc, int fr, int fq) const {
        const int row0 = u.pm * BM + wr * 64 + fr;
#pragma unroll
        for (int ai = 0; ai < 2; ++ai)
#pragma unroll
            for (int m = 0; m < 4; ++m) {
                const int r = row0 + ai * HALF + m * 16;
                float* rp = S + ((size_t)u.g * NBC + r) * 256 + wc * 32 + 8 * fq;
#pragma unroll
                for (int bj = 0; bj < 2; ++bj) { *(f32x4*)(rp + bj * HALF) = acc[ai][bj][m][0]; *(f32x4*)(rp + bj * HALF + 4) = acc[ai][bj][m][1]; }
            }
    }
};
struct EpiY {
    bf16_t* Z;
    __device__ __forceinline__ void operator()(const f32x4 (&acc)[2][2][4][2], const Unit& u, int wr, int wc, int fr, int fq) const {
        const int row0 = u.pm * BM + wr * 64 + fr;
#pragma unroll
        for (int ai = 0; ai < 2; ++ai)
#pragma unroll
            for (int m = 0; m < 4; ++m) {
                const int bc = row0 + ai * HALF + m * 16;
#pragma unroll
                for (int bj = 0; bj < 2; ++bj) {
                    const int c0 = u.pn * BM + bj * HALF + wc * 32 + 8 * fq, j = c0 >> 4, h0 = c0 & 15;
                    f32x4 v0 = acc[ai][bj][m][0], v1 = acc[ai][bj][m][1];
#pragma unroll
                    for (int q = 0; q < 4; ++q) { v0[q] = gelu_t(v0[q]); v1[q] = gelu_t(v1[q]); }
                    *(u32x4*)(Z + ((size_t)bc * TCH + j) * DIN + 512 + u.g * 16 + h0) = pack8(v0, v1);
                }
            }
    }
};
struct EpiGlu {
    const bf16_t* Z; bf16_t* CAT; const float* bias;
    __device__ __forceinline__ void operator()(const f32x4 (&acc)[2][2][4][2], const Unit& u, int wr, int wc, int fr, int fq) const {
        const int row0 = u.pm * BM + wr * 64 + fr;
#pragma unroll
        for (int bj = 0; bj < 2; ++bj) {
            const int c0 = u.pn * BM + bj * HALF + wc * 32 + 8 * fq;
            const f32x4 b0 = *(const f32x4*)(bias + c0), b1 = *(const f32x4*)(bias + c0 + 4);
#pragma unroll
            for (int ai = 0; ai < 2; ++ai)
#pragma unroll
                for (int m = 0; m < 4; ++m) {
                    const int r = row0 + ai * HALF + m * 16;
                    const u32x4 gw = *(const u32x4*)(Z + (size_t)r * DIN + 512 + c0);
                    f32x4 v0 = acc[ai][bj][m][0] + b0, v1 = acc[ai][bj][m][1] + b1;
                    v0[0] = bf_lo(gw.x) * sigmoid_f(v0[0]); v0[1] = bf_hi(gw.x) * sigmoid_f(v0[1]); v0[2] = bf_lo(gw.y) * sigmoid_f(v0[2]); v0[3] = bf_hi(gw.y) * sigmoid_f(v0[3]);
                    v1[0] = bf_lo(gw.z) * sigmoid_f(v1[0]); v1[1] = bf_hi(gw.z) * sigmoid_f(v1[1]); v1[2] = bf_lo(gw.w) * sigmoid_f(v1[2]); v1[3] = bf_hi(gw.w) * sigmoid_f(v1[3]);
                    *(u32x4*)(CAT + (size_t)r * D + 256 + c0) = pack8(v0, v1);
                }
        }
    }
};
struct EpiBf {
    bf16_t* O; int ldc;
    __device__ __forceinline__ void operator()(const f32x4 (&acc)[2][2][4][2], const Unit& u, int wr, int wc, int fr, int fq) const {
        const int row0 = u.pm * BM + wr * 64 + fr, col0 = u.pn * BM + wc * 32 + 8 * fq;
#pragma unroll
        for (int ai = 0; ai < 2; ++ai)
#pragma unroll
            for (int m = 0; m < 4; ++m) {
                bf16_t* rp = O + (size_t)(row0 + ai * HALF + m * 16) * ldc + col0;
#pragma unroll
                for (int bj = 0; bj < 2; ++bj) *(u32x4*)(rp + bj * HALF) = pack8(acc[ai][bj][m][0], acc[ai][bj][m][1]);
            }
    }
};
struct EpiGU {
    bf16_t* HID;
    __device__ __forceinline__ void operator()(const f32x4 (&acc)[2][2][4][2], const Unit& u, int wr, int wc, int fr, int fq) const {
        const int row0 = u.pm * BM + wr * 64 + fr, col0 = u.pn * HALF + wc * 32 + 8 * fq;
#pragma unroll
        for (int ai = 0; ai < 2; ++ai)
#pragma unroll
            for (int m = 0; m < 4; ++m) {
                f32x4 v0, v1;
#pragma unroll
                for (int j = 0; j < 4; ++j) { v0[j] = silu_f(acc[ai][0][m][0][j]) * acc[ai][1][m][0][j]; v1[j] = silu_f(acc[ai][0][m][1][j]) * acc[ai][1][m][1][j]; }
                *(u32x4*)(HID + (size_t)(row0 + ai * HALF + m * 16) * DFF + col0) = pack8(v0, v1);
            }
    }
};

__device__ __forceinline__ void transpose_tile(const float* W, int K, int N, bf16_t* WT, int mode, int tile, LAS float* scr) {
    const int t = tid_l(), nblk = N / 64, kb = tile / nblk, nb = tile % nblk, k0 = kb * 64, n0 = nb * 64;
#pragma unroll
    for (int i = 0; i < 8; ++i) { const int idx = t + 512 * i, k = idx >> 6, n = idx & 63; scr[k * 65 + n] = W[(size_t)(k0 + k) * N + n0 + n]; }
    __syncthreads();
#pragma unroll
    for (int i = 0; i < 4; ++i) { const int idx = t + 512 * i, n = idx >> 5, kp = idx & 31;
        const int ncol = n0 + n; int drow = ncol;
        if (mode == 1) drow = 256 * (ncol >> 7) + (ncol & 127); else if (mode == 2) drow = 256 * (ncol >> 7) + 128 + (ncol & 127);
        *(unsigned*)(WT + (size_t)drow * K + k0 + 2 * kp) = cvt_pk_bf16(scr[(2 * kp) * 65 + n], scr[(2 * kp + 1) * 65 + n]); }
    __syncthreads();
}

__device__ void p0_mod_slab(const Params& p, int sl, LAS float* lds) {
    const int t = tid_l(), l = sl / 96, n0 = (sl % 96) * 64, col = t & 63, ks = t >> 6;
    const float* W = p.in[4] + (size_t)l * D * 6144; const float* bm = p.in[5] + (size_t)l * 6144;
    LAS float* sv = lds;
    LAS float* red = lds + 33 * 512;
    float acc[33];
#pragma unroll
    for (int b = 0; b < 33; ++b) acc[b] = 0.f;
    for (int half = 0; half < 2; ++half) {
        __syncthreads();
        for (int i = t; i < 33 * 512; i += 512) { const int b = i >> 9, k = (i & 511) + half * 512; const float cv = b < 32 ? p.in[1][b * D + k] : p.in[3][k]; sv[i] = silu_f(cv); }
        __syncthreads();
        for (int kk = 0; kk < 64; kk += 4) {
            const int kl = ks * 64 + kk, kg = half * 512 + kl;
            const float w0 = W[(size_t)(kg + 0) * 6144 + n0 + col], w1 = W[(size_t)(kg + 1) * 6144 + n0 + col], w2 = W[(size_t)(kg + 2) * 6144 + n0 + col], w3 = W[(size_t)(kg + 3) * 6144 + n0 + col];
#pragma unroll
            for (int b = 0; b < 33; ++b) { const f32x4 s = *(const LAS f32x4*)(sv + b * 512 + kl); acc[b] += s[0] * w0 + s[1] * w1 + s[2] * w2 + s[3] * w3; }
        }
    }
#pragma unroll
    for (int b = 0; b < 33; ++b) red[(ks * 33 + b) * 64 + col] = acc[b];
    __syncthreads();
    float* MOD = (float*)(p.ws + WS_MOD) + (size_t)l * 33 * 6144;
    for (int i = t; i < 33 * 64; i += 512) { const int b = i >> 6, cc = i & 63; float s = bm[n0 + cc];
#pragma unroll
        for (int k8 = 0; k8 < 8; ++k8) s += red[(k8 * 33 + b) * 64 + cc];
        MOD[(size_t)b * 6144 + n0 + cc] = s; }
    __syncthreads();
}

__device__ void p0_ssm_tables(const Params& p, int lg, LAS float* lds) {
    const int t = tid_l(), l = lg >> 5, g = lg & 31;
    LAS f32x2* lamp = (LAS f32x2*)lds;
    LAS f32x2* bbar = lamp + 2 * 64 * 33;
    LAS f32x2* cc = bbar + 2 * 64 * 16;
    f32x2* gl = (f32x2*)(p.ws + WS_LAMP) + (size_t)lg * 2 * 64 * 33;
    f32x2* gb = (f32x2*)(p.ws + WS_BBAR) + (size_t)lg * 2 * 64 * 16;
    __syncthreads();
    for (int i = t; i < 2 * 64 * 33; i += 512) {
        const int dir = i / (64 * 33), pp = (i / 33) % 64, n = i % 33;
        const size_t li = ((size_t)(l * 2 + dir) * 32 + g) * 64 + pp;
        const float dt = expf(p.in[16][(l * 2 + dir) * 32 + g]);
        const float a = p.in[14][li] * dt, b = p.in[15][li] * dt;
        const float mag = expf(a * (float)n); float sn, cs; sincosf(b * (float)n, &sn, &cs);
        const f32x2 v = {mag * cs, mag * sn}; lamp[i] = v; gl[i] = v;
    }
    for (int i = t; i < 2 * 64 * 16; i += 512) {
        const int dir = i / (64 * 16), pp = (i / 16) % 64, h = i % 16;
        const size_t li = ((size_t)(l * 2 + dir) * 32 + g) * 64 + pp;
        const float dt = expf(p.in[16][(l * 2 + dir) * 32 + g]);
        const float lr = p.in[14][li], lim = p.in[15][li];
        const float a = lr * dt, b = lim * dt;
        float sn, cs; sincosf(b, &sn, &cs); const float sh = sinf(0.5f * b);
        const float xr = expm1f(a) * cs - 2.0f * sh * sh, xi = expf(a) * sn;
        const float den = 1.0f / (lr * lr + lim * lim);
        const float qr = (xr * lr + xi * lim) * den, qi = (xi * lr - xr * lim) * den;
        const float br = p.in[17][li * 16 + h], bi = p.in[18][li * 16 + h];
        const f32x2 v = {qr * br - qi * bi, qr * bi + qi * br}; bbar[i] = v; gb[i] = v;
    }
    for (int i = t; i < 2 * 16 * 64; i += 512) {
        const int dir = i / 1024, h = (i / 64) % 16, pp = i % 64;
        const size_t ci = (((size_t)(l * 2 + dir) * 32 + g) * 16 + h) * 64 + pp;
        cc[i] = (f32x2){p.in[19][ci], p.in[20][ci]};
    }
    __syncthreads();
    float* KT = (float*)(p.ws + WS_KT) + (size_t)lg * 2 * 32 * 256;
    for (int e = t; e < 2 * 32 * 256; e += 512) {
        const int dir = e >> 13, n = (e >> 8) & 31, h = (e >> 4) & 15, hp = e & 15;
        float s = 0.f;
        for (int pp = 0; pp < 64; ++pp) {
            const f32x2 c = cc[(dir * 16 + h) * 64 + pp], lm = lamp[(dir * 64 + pp) * 33 + n], bb = bbar[(dir * 64 + pp) * 16 + hp];
            const float tr = c.x * lm.x - c.y * lm.y, ti = c.x * lm.y + c.y * lm.x;
            s += tr * bb.x - ti * bb.y;
        }
        KT[e] = s;
    }
    __syncthreads();
}

__device__ void phase_p0(const Params& p, LAS unsigned char* lds) {
    const int t = tid_l(), w = blockIdx.x, G = gridDim.x;
    if (w < 64) p0_ssm_tables(p, w, (LAS float*)lds);
    for (int sl = (w >= 64 ? w - 64 : w + G - 64); sl < 192; sl += G) p0_mod_slab(p, sl, (LAS float*)lds);
    {
        constexpr int T_IN = 16 * 20, T_OUT = 16 * 16, T_GLU = 8 * 8, T_G = 16 * 44, T_D = 44 * 16, T_L = T_IN + T_OUT + T_GLU + 2 * T_G + T_D;
        LAS float* scr = (LAS float*)lds;
        for (int it = w; it < 2 * T_L; it += G) {
            const int l = it / T_L; int r = it % T_L;
            if (r < T_IN) { transpose_tile(p.in[10] + (size_t)l * D * DIN, D, DIN, (bf16_t*)(p.ws + WS_WINT) + (size_t)l * DIN * D, 0, r, scr); continue; } r -= T_IN;
            if (r < T_OUT) { transpose_tile(p.in[11] + (size_t)l * D * D, D, D, (bf16_t*)(p.ws + WS_WOUTT) + (size_t)l * D * D, 0, r, scr); continue; } r -= T_OUT;
            if (r < T_GLU) { transpose_tile(p.in[22] + (size_t)l * 512 * 512, 512, 512, (bf16_t*)(p.ws + WS_GLUT) + (size_t)l * 512 * 512, 0, r, scr); continue; } r -= T_GLU;
            if (r < T_G) { transpose_tile(p.in[26] + (size_t)l * D * DFF, D, DFF, (bf16_t*)(p.ws + WS_WGUT) + (size_t)l * 2 * DFF * D, 1, r, scr); continue; } r -= T_G;
            if (r < T_G) { transpose_tile(p.in[27] + (size_t)l * D * DFF, D, DFF, (bf16_t*)(p.ws + WS_WGUT) + (size_t)l * 2 * DFF * D, 2, r, scr); continue; } r -= T_G;
            transpose_tile(p.in[28] + (size_t)l * DFF * D, DFF, D, (bf16_t*)(p.ws + WS_WDT) + (size_t)l * D * DFF, 0, r, scr);
        }
    }
    const int gt = w * 512 + t, GT = G * 512;
    { float* pe = (float*)(p.ws + WS_PE);
      for (int i = gt; i < 96 * 512; i += GT) { const int pos = i >> 9, cidx = i & 511, k = cidx & 255; const int ps = pos < 32 ? pos : pos - 32;
          const float om = expf(-9.210340371976184f * (float)k * (1.0f / 256.0f)); const float ang = (float)ps * om; pe[i] = cidx < 256 ? sinf(ang) : cosf(ang); } }
    { bf16_t* sw = (bf16_t*)(p.ws + WS_SGUW); for (int i = gt; i < 2 * 4 * 128 * 128 / 2; i += GT) *(unsigned*)(sw + 2 * i) = cvt_pk_bf16(p.in[12][2 * i], p.in[12][2 * i + 1]);
      bf16_t* pw = (bf16_t*)(p.ws + WS_POOLWT); for (int i = gt; i < 2 * 4 * 64 * 64; i += GT) { const int li = i >> 12, o = (i >> 6) & 63, ch = i & 63; pw[i] = (bf16_t)(cvt_pk_bf16(p.in[24][(size_t)li * 4096 + ch * 64 + o], 0.f) & 0xffffu); } }
}

struct RowIn { f32x4 x[4]; f32x4 pe[4]; u32x2 s[4]; };
template <bool PE, bool SRC>
__device__ __forceinline__ void row_load(RowIn& d, const float* xin, const float* per, const float* pec, const bf16_t* src, int lane) {
#pragma unroll
    for (int j = 0; j < 4; ++j) d.x[j] = *(const f32x4*)(xin + 4 * lane + 256 * j);
    if (PE) {
#pragma unroll
        for (int j = 0; j < 2; ++j) { d.pe[j] = *(const f32x4*)(per + 4 * lane + 256 * j); d.pe[j + 2] = *(const f32x4*)(pec + 4 * lane + 256 * j); }
    }
    if (SRC) {
#pragma unroll
        for (int j = 0; j < 4; ++j) d.s[j] = *(const u32x2*)(src + 4 * lane + 256 * j);
    }
}
template <bool PE, bool SRC, bool XOUT, bool HOUT>
__device__ __forceinline__ void row_compute(const RowIn& d, const f32x4 (&Av)[4], const f32x4 (&Bv)[4], const f32x4 (&Cv)[4], float* xout, bf16_t* hout, int lane) {
    f32x4 x[4];
#pragma unroll
    for (int j = 0; j < 4; ++j) { x[j] = d.x[j]; if (PE) x[j] += d.pe[j]; }
    if (SRC) {
        f32x4 s[4]; float ss = 0.f;
#pragma unroll
        for (int j = 0; j < 4; ++j) { s[j] = (f32x4){bf_lo(d.s[j].x), bf_hi(d.s[j].x), bf_lo(d.s[j].y), bf_hi(d.s[j].y)}; ss += (s[j][0] * s[j][0] + s[j][1] * s[j][1]) + (s[j][2] * s[j][2] + s[j][3] * s[j][3]); }
        const float rstd = rsqrtf(wave_sum(ss) * (1.0f / D) + EPS);
#pragma unroll
        for (int j = 0; j < 4; ++j) x[j] += Av[j] * (s[j] * rstd);
    }
    if (XOUT) {
#pragma unroll
        for (int j = 0; j < 4; ++j) *(f32x4*)(xout + 4 * lane + 256 * j) = x[j];
    }
    if (HOUT) {
        float ss = 0.f;
#pragma unroll
        for (int j = 0; j < 4; ++j) ss += (x[j][0] * x[j][0] + x[j][1] * x[j][1]) + (x[j][2] * x[j][2] + x[j][3] * x[j][3]);
        const float rstd = rsqrtf(wave_sum(ss) * (1.0f / D) + EPS);
#pragma unroll
        for (int j = 0; j < 4; ++j) { const f32x4 h = (x[j] * rstd) * Bv[j] + Cv[j];
            *(u32x2*)(hout + 4 * lane + 256 * j) = (u32x2){cvt_pk_bf16(h[0], h[1]), cvt_pk_bf16(h[2], h[3])}; }
    }
}
template <bool PE, bool SRC, bool XOUT, bool HOUT>
__device__ __forceinline__ void rows_run(const float* xin, const float* pe, int tok0, const bf16_t* src, float* xout, bf16_t* hout, int nr,
                                         const f32x4 (&Av)[4], const f32x4 (&Bv)[4], const f32x4 (&Cv)[4], int lane) {
    RowIn cur, nxt;
    row_load<PE, SRC>(cur, xin, PE ? pe + (tok0 >> 6) * 512 : nullptr, PE ? pe + (32 + (tok0 & 63)) * 512 : nullptr, src, lane);
    for (int i = 0; i < nr; ++i) {
        if (i + 1 < nr) { const int tk = tok0 + i + 1;
            row_load<PE, SRC>(nxt, xin + (size_t)(i + 1) * D, PE ? pe + (tk >> 6) * 512 : nullptr, PE ? pe + (32 + (tk & 63)) * 512 : nullptr, SRC ? src + (size_t)(i + 1) * D : nullptr, lane); }
        row_compute<PE, SRC, XOUT, HOUT>(cur, Av, Bv, Cv, XOUT ? xout + (size_t)i * D : nullptr, HOUT ? hout + (size_t)i * D : nullptr, lane);
        cur = nxt;
    }
}
__device__ __forceinline__ void row_vecs(f32x4 (&Av)[4], f32x4 (&Bv)[4], f32x4 (&Cv)[4], const float* gate, const float* wpost, const float* wpre, const float* sh, const float* sc, int lane) {
#pragma unroll
    for (int j = 0; j < 4; ++j) { const int o = 4 * lane + 256 * j;
        Av[j] = gate ? *(const f32x4*)(gate + o) * *(const f32x4*)(wpost + o) : (f32x4){0.f, 0.f, 0.f, 0.f};
        if (wpre) { Bv[j] = *(const f32x4*)(wpre + o) * (1.0f + *(const f32x4*)(sc + o)); Cv[j] = *(const f32x4*)(sh + o); } else { Bv[j] = (f32x4){0.f, 0.f, 0.f, 0.f}; Cv[j] = Bv[j]; } }
}

__device__ void phase_p1(const Params& p) {
    const int t = tid_l(), w = blockIdx.x, G = gridDim.x, lane = t & 63;
    const size_t gt = (size_t)w * 512 + t, GT = (size_t)G * 512;
    { bf16_t* SM = (bf16_t*)(p.ws + WS_SMAT); const f32x2* gl = (const f32x2*)(p.ws + WS_LAMP); const f32x2* gb = (const f32x2*)(p.ws + WS_BBAR);
      for (size_t it = gt; it < (size_t)2 * 32 * 256 * 64; it += GT) {
          const int k8 = (int)(it & 63), n = (int)((it >> 6) & 255), lg = (int)(it >> 14);
          const int dir = n >> 7, pp = (n >> 1) & 63, ri = n & 1, s = k8 >> 1, h0 = (k8 & 1) * 8, e = dir == 0 ? 31 - s : s;
          const f32x2 lm = gl[((size_t)(lg * 2 + dir) * 64 + pp) * 33 + e]; const f32x2* bb = gb + ((size_t)(lg * 2 + dir) * 64 + pp) * 16 + h0;
          float v[8];
#pragma unroll
          for (int j = 0; j < 8; ++j) { const f32x2 b = bb[j]; v[j] = ri ? (lm.x * b.y + lm.y * b.x) : (lm.x * b.x - lm.y * b.y); }
          u32x4 o; o.x = cvt_pk_bf16(v[0], v[1]); o.y = cvt_pk_bf16(v[2], v[3]); o.z = cvt_pk_bf16(v[4], v[5]); o.w = cvt_pk_bf16(v[6], v[7]);
          *(u32x4*)(SM + it * 8) = o; } }
    { bf16_t* YM = (bf16_t*)(p.ws + WS_YMAT); const float* KT = (const float*)(p.ws + WS_KT); const f32x2* gl = (const f32x2*)(p.ws + WS_LAMP);
      for (size_t it = gt; it < (size_t)2 * 32 * 512 * 96; it += GT) {
          const int k8 = (int)(it % 96); const size_t rr = it / 96; const int row = (int)(rr & 511), lg = (int)(rr >> 9), l = lg >> 5, g = lg & 31, j = row >> 4, h = row & 15;
          float v[8];
          if (k8 < 64) {
              const int s = k8 >> 1, h0 = (k8 & 1) * 8, n = j - s;
              if (n > 0) { const float* kp = KT + (((size_t)lg * 2 + 0) * 32 + n) * 256 + h * 16 + h0;
#pragma unroll
                  for (int q = 0; q < 8; ++q) v[q] = kp[q]; }
              else if (n < 0) { const float* kp = KT + (((size_t)lg * 2 + 1) * 32 + (-n)) * 256 + h * 16 + h0;
#pragma unroll
                  for (int q = 0; q < 8; ++q) v[q] = kp[q]; }
              else { const float* k0 = KT + (((size_t)lg * 2 + 0) * 32) * 256 + h * 16 + h0; const float* k1 = KT + (((size_t)lg * 2 + 1) * 32) * 256 + h * 16 + h0; const float dd = p.in[21][(l * 32 + g) * 16 + h];
#pragma unroll
                  for (int q = 0; q < 8; ++q) v[q] = k0[q] + k1[q] + ((h0 + q) == h ? dd : 0.f); }
          } else {
              const int kk = (k8 - 64) * 8, dir = kk >> 7, p0 = (kk & 127) >> 1, e = dir == 0 ? j + 1 : 32 - j;
#pragma unroll
              for (int q = 0; q < 4; ++q) { const int pp = p0 + q; const size_t ci = (((size_t)(l * 2 + dir) * 32 + g) * 16 + h) * 64 + pp;
                  const float cr = p.in[19][ci], cim = p.in[20][ci]; const f32x2 lm = gl[((size_t)(lg * 2 + dir) * 64 + pp) * 33 + e];
                  v[2 * q] = cr * lm.x - cim * lm.y; v[2 * q + 1] = -(cr * lm.y + cim * lm.x); }
          }
          u32x4 o; o.x = cvt_pk_bf16(v[0], v[1]); o.y = cvt_pk_bf16(v[2], v[3]); o.z = cvt_pk_bf16(v[4], v[5]); o.w = cvt_pk_bf16(v[6], v[7]);
          *(u32x4*)(YM + it * 8) = o; } }
    { const float* MOD = (const float*)(p.ws + WS_MOD); const float* pe = (const float*)(p.ws + WS_PE); bf16_t* H = (bf16_t*)(p.ws + WS_H);
      const int gw = w * 8 + (t >> 6), NW = G * 8, RL = NLAT / NW, RC = NCTX / NW;
      f32x4 Av[4], Bv[4], Cv[4];
      { const int r0 = gw * RL, b = r0 >> 11; const float* mb = MOD + (size_t)b * 6144;
        row_vecs(Av, Bv, Cv, nullptr, nullptr, p.in[6], mb, mb + 1024, lane);
        rows_run<true, false, false, true>(p.in[0] + (size_t)r0 * D, pe, r0 & 2047, nullptr, nullptr, H + (size_t)r0 * D, RL, Av, Bv, Cv, lane); }
      { const int rc = gw * RC; const float* mb = MOD + (size_t)32 * 6144;
        row_vecs(Av, Bv, Cv, nullptr, nullptr, p.in[6], mb, mb + 1024, lane);
        rows_run<false, false, false, true>(p.in[2] + (size_t)rc * D, nullptr, 0, nullptr, nullptr, H + (size_t)(NLAT + rc) * D, RC, Av, Bv, Cv, lane); }
    }
}

__device__ void phase_post(const Params& p, int l, int which) {
    const int t = tid_l(), lane = t & 63, gw = blockIdx.x * 8 + (t >> 6), NW = gridDim.x * 8, RL = NLAT / NW, RC = NCTX / NW;
    const float* MOD = (const float*)(p.ws + WS_MOD) + (size_t)l * 33 * 6144; bf16_t* H = (bf16_t*)(p.ws + WS_H);
    const float* pe = (const float*)(p.ws + WS_PE);
    const bf16_t* SRC = (const bf16_t*)(p.ws + (which == 0 ? WS_MOUT : WS_F));
    const float* wpost = (which == 0 ? p.in[7] : p.in[9]) + (size_t)l * D;
    const bool hasH = (which == 0) || (l == 0);
    const int ln = l + 1 < 2 ? l + 1 : 1;
    const float* wpre = which == 0 ? p.in[8] + (size_t)l * D : p.in[6] + (size_t)ln * D;
    const float* MODN = which == 0 ? MOD : (const float*)(p.ws + WS_MOD) + (size_t)ln * 33 * 6144;
    const bool first = (l == 0 && which == 0);
    f32x4 Av[4], Bv[4], Cv[4];
    {   const int r0 = gw * RL, b = r0 >> 11; const float* mb = MOD + (size_t)b * 6144; const float* mn = MODN + (size_t)b * 6144;
        row_vecs(Av, Bv, Cv, mb + (which == 0 ? 2048 : 5120), wpost, hasH ? wpre : nullptr, mn + (which == 0 ? 3072 : 0), mn + (which == 0 ? 4096 : 1024), lane);
        float* xo = p.out + (size_t)r0 * D; const bf16_t* sr = SRC + (size_t)r0 * D; bf16_t* ho = H + (size_t)r0 * D;
        if (first) rows_run<true, true, true, true>(p.in[0] + (size_t)r0 * D, pe, r0 & 2047, sr, xo, ho, RL, Av, Bv, Cv, lane);
        else if (hasH) rows_run<false, true, true, true>(xo, nullptr, 0, sr, xo, ho, RL, Av, Bv, Cv, lane);
        else rows_run<false, true, true, false>(xo, nullptr, 0, sr, xo, nullptr, RL, Av, Bv, Cv, lane); }
    if (l == 0) { const int rc = gw * RC; const float* mb = MOD + (size_t)32 * 6144; const float* mn = MODN + (size_t)32 * 6144;
        row_vecs(Av, Bv, Cv, mb + (which == 0 ? 2048 : 5120), wpost, wpre, mn + (which == 0 ? 3072 : 0), mn + (which == 0 ? 4096 : 1024), lane);
        float* xo = (float*)(p.ws + WS_XCTX) + (size_t)rc * D; const bf16_t* sr = SRC + (size_t)(NLAT + rc) * D; bf16_t* ho = H + (size_t)(NLAT + rc) * D;
        if (first) rows_run<false, true, true, true>(p.in[2] + (size_t)rc * D, nullptr, 0, sr, xo, ho, RC, Av, Bv, Cv, lane);
        else rows_run<false, true, true, true>(xo, nullptr, 0, sr, xo, ho, RC, Av, Bv, Cv, lane); }
}

__device__ void sgu_items(const Params& p, int l, LAS unsigned char* lds) {
    const int t = tid_l(), lane = t & 63, wv = t >> 6, fr = lane & 15, fq = lane >> 4;
    const bf16_t* Z = (const bf16_t*)(p.ws + WS_Z); bf16_t* CAT = (bf16_t*)(p.ws + WS_CAT);
    const bf16_t* SW = (const bf16_t*)(p.ws + WS_SGUW) + (size_t)l * 4 * 128 * 128; const float* sb = p.in[13] + (size_t)l * 4 * 128;
    LAS bf16_t* Vt = (LAS bf16_t*)lds;
    const int nitems = ((l == 0) ? MTOT : NLAT) / 128 * 4;
    for (int it = blockIdx.x; it < nitems; it += gridDim.x) {
        const int ck = it >> 2, h = it & 3;
        {
            const int q = t >> 2, part = t & 3; const bf16_t* vp = Z + (size_t)(ck * 128 + q) * DIN + 256 + 64 * h + part * 16;
            const u32x4 w0 = *(const u32x4*)vp, w1 = *(const u32x4*)(vp + 8);
            float v[16] = {bf_lo(w0.x), bf_hi(w0.x), bf_lo(w0.y), bf_hi(w0.y), bf_lo(w0.z), bf_hi(w0.z), bf_lo(w0.w), bf_hi(w0.w), bf_lo(w1.x), bf_hi(w1.x), bf_lo(w1.y), bf_hi(w1.y), bf_lo(w1.z), bf_hi(w1.z), bf_lo(w1.w), bf_hi(w1.w)};
            float s = 0.f;
#pragma unroll
            for (int i = 0; i < 16; ++i) s += v[i];
            s += __shfl_xor(s, 1); s += __shfl_xor(s, 2); const float mu = s * (1.0f / 64.0f); float q2 = 0.f;
#pragma unroll
            for (int i = 0; i < 16; ++i) { v[i] -= mu; q2 += v[i] * v[i]; }
            q2 += __shfl_xor(q2, 1); q2 += __shfl_xor(q2, 2); const float rstd = rsqrtf(q2 * (1.0f / 64.0f) + EPS);
#pragma unroll
            for (int i = 0; i < 16; ++i) Vt[(part * 16 + i) * 136 + q] = (bf16_t)(cvt_pk_bf16(v[i] * rstd, 0.f) & 0xffffu);
        }
        __syncthreads();
        f32x4 acc[4];
#pragma unroll
        for (int dt = 0; dt < 4; ++dt) acc[dt] = (f32x4){0.f, 0.f, 0.f, 0.f};
        const int p0 = 16 * wv;
#pragma unroll
        for (int kq = 0; kq < 4; ++kq) {
            const bf16x8 wf = *(const bf16x8*)(SW + ((size_t)h * 128 + p0 + fr) * 128 + kq * 32 + fq * 8);
#pragma unroll
            for (int dt = 0; dt < 4; ++dt) { const bf16x8 vf = *(const LAS bf16x8*)(Vt + (16 * dt + fr) * 136 + kq * 32 + fq * 8); acc[dt] = __builtin_amdgcn_mfma_f32_16x16x32_bf16(vf, wf, acc[dt], 0, 0, 0); }
        }
        {
            const int pt = p0 + fr; const float bias = sb[h * 128 + pt]; const size_t row = (size_t)ck * 128 + pt;
#pragma unroll
            for (int dt = 0; dt < 4; ++dt) { const int dcol = 64 * h + 16 * dt + 4 * fq; const u32x2 uw = *(const u32x2*)(Z + row * DIN + dcol);
                const float o0 = bf_lo(uw.x) * (acc[dt][0] + bias), o1 = bf_hi(uw.x) * (acc[dt][1] + bias), o2 = bf_lo(uw.y) * (acc[dt][2] + bias), o3 = bf_hi(uw.y) * (acc[dt][3] + bias);
                *(u32x2*)(CAT + row * D + dcol) = (u32x2){cvt_pk_bf16(o0, o1), cvt_pk_bf16(o2, o3)}; }
        }
        __syncthreads();
    }
}

__device__ void pool_items(const Params& p, int l, LAS unsigned char* lds) {
    const int t = tid_l(), lane = t & 63, wv = t >> 6, fr = lane & 15, fq = lane >> 4;
    const bf16_t* Z = (const bf16_t*)(p.ws + WS_Z); bf16_t* CAT = (bf16_t*)(p.ws + WS_CAT);
    const bf16_t* PW = (const bf16_t*)(p.ws + WS_POOLWT) + (size_t)l * 4 * 64 * 64; const float* psc = p.in[25] + (size_t)l * 256;
    LAS bf16_t* Pl = (LAS bf16_t*)lds;
    LAS bf16_t* Dl = Pl + 256 * 72;
    const int nitems = ((l == 0) ? MTOT : NLAT) / 256 * 4;
    for (int it = blockIdx.x; it < nitems; it += gridDim.x) {
        const int pt = it >> 2, i = it & 3, wdw = 2 << i;
        const int row = t >> 1, half = t & 1;
        { const bf16_t* src = Z + (size_t)(pt * 256 + row) * DIN + 1024 + 64 * i + half * 32;
#pragma unroll
          for (int q = 0; q < 4; ++q) *(LAS u32x4*)(Pl + row * 72 + half * 32 + q * 8) = *(const u32x4*)(src + q * 8); }
        __syncthreads();
        { const int seg = pt < 256 ? 64 : 256, pos = row & (seg - 1), sb = row - pos;
          int lo = pos - wdw / 2; int hi = lo + wdw; lo = lo < 0 ? 0 : lo; hi = hi > seg ? seg : hi; const float inv = 1.0f / (float)(hi - lo);
#pragma unroll
          for (int q = 0; q < 4; ++q) {
              float s[8];
#pragma unroll
              for (int e = 0; e < 8; ++e) s[e] = 0.f;
              for (int tau = lo; tau < hi; ++tau) { const u32x4 w = *(const LAS u32x4*)(Pl + (sb + tau) * 72 + half * 32 + q * 8);
                  s[0] += bf_lo(w.x); s[1] += bf_hi(w.x); s[2] += bf_lo(w.y); s[3] += bf_hi(w.y); s[4] += bf_lo(w.z); s[5] += bf_hi(w.z); s[6] += bf_lo(w.w); s[7] += bf_hi(w.w); }
              const u32x4 w = *(const LAS u32x4*)(Pl + row * 72 + half * 32 + q * 8);
              const float c[8] = {bf_lo(w.x), bf_hi(w.x), bf_lo(w.y), bf_hi(w.y), bf_lo(w.z), bf_hi(w.z), bf_lo(w.w), bf_hi(w.w)};
              u32x4 o; o.x = cvt_pk_bf16(s[0] * inv - c[0], s[1] * inv - c[1]); o.y = cvt_pk_bf16(s[2] * inv - c[2], s[3] * inv - c[3]);
              o.z = cvt_pk_bf16(s[4] * inv - c[4], s[5] * inv - c[5]); o.w = cvt_pk_bf16(s[6] * inv - c[6], s[7] * inv - c[7]);
              *(LAS u32x4*)(Dl + row * 72 + half * 32 + q * 8) = o; } }
        __syncthreads();
        f32x4 acc[2][4];
#pragma unroll
        for (int a = 0; a < 2; ++a)
#pragma unroll
            for (int o = 0; o < 4; ++o) acc[a][o] = (f32x4){0.f, 0.f, 0.f, 0.f};
#pragma unroll
        for (int kc = 0; kc < 2; ++kc) {
            bf16x8 df[2];
#pragma unroll
            for (int a = 0; a < 2; ++a) df[a] = *(const LAS bf16x8*)(Dl + (32 * wv + 16 * a + fr) * 72 + kc * 32 + fq * 8);
#pragma unroll
            for (int o = 0; o < 4; ++o) { const bf16x8 wf = *(const bf16x8*)(PW + ((size_t)i * 64 + 16 * o + fr) * 64 + kc * 32 + fq * 8);
#pragma unroll
                for (int a = 0; a < 2; ++a) acc[a][o] = __builtin_amdgcn_mfma_f32_16x16x32_bf16(wf, df[a], acc[a][o], 0, 0, 0); }
        }
#pragma unroll
        for (int a = 0; a < 2; ++a) { const size_t r = (size_t)pt * 256 + 32 * wv + 16 * a + fr;
#pragma unroll
            for (int o = 0; o < 4; ++o) { const int oc = 64 * i + 16 * o + 4 * fq; const f32x4 sc = *(const f32x4*)(psc + oc); const f32x4 v = acc[a][o] * sc;
                *(u32x2*)(CAT + r * D + 768 + oc) = (u32x2){cvt_pk_bf16(v[0], v[1]), cvt_pk_bf16(v[2], v[3])}; } }
        __syncthreads();
    }
}

__device__ void phase_scan(const Params& p, int l) {
    const size_t gt = (size_t)blockIdx.x * 512 + tid_l(), GT = (size_t)gridDim.x * 512;
    const float* S = (const float*)(p.ws + WS_S); bf16_t* U = (bf16_t*)(p.ws + WS_USSM); const f32x2* gl = (const f32x2*)(p.ws + WS_LAMP);
    for (size_t id = gt; id < (size_t)NB * 32 * 128; id += GT) {
        const int dp = (int)(id & 127), dir = dp >> 6, pp = dp & 63, g = (int)((id >> 7) & 31), b = (int)(id >> 12);
        const f32x2 lt = gl[((size_t)((l * 32 + g) * 2 + dir) * 64 + pp) * 33 + 32];
        float hr = 0.f, hi = 0.f;
        for (int st = 0; st < 72; ++st) {
            int bc;
            if (st < 8) bc = 2048 + 8 * b + (dir == 0 ? st : 7 - st);
            else bc = 64 * b + (dir == 0 ? st - 8 : 71 - st);
            const size_t rowi = (size_t)g * NBC + bc;
            const f32x2 sv = *(const f32x2*)(S + rowi * 256 + dir * 128 + 2 * pp);
            *(unsigned*)(U + rowi * KY + 512 + dir * 128 + 2 * pp) = cvt_pk_bf16(hr, hi);
            const float nr = lt.x * hr - lt.y * hi + sv.x, ni = lt.x * hi + lt.y * hr + sv.y;
            hr = nr; hi = ni;
        }
    }
}

#define XB_TMO      128
#define XB_XCNT(j)  (256  + 64 * (j))
#define XB_XSUB(j)  (1280 + 64 * (j))
#define XB_XGEN(j)  (2304 + 64 * (j))
#define XB_TOP      3328
#define XB_TOPGEN   3392
#define XCD_BAR_WORDS 3456
#define XB_SPIN_CAP (1u << 22)
__device__ __forceinline__ unsigned xb_ld(unsigned* p)              { return __hip_atomic_load(p, __ATOMIC_RELAXED, __HIP_MEMORY_SCOPE_AGENT); }
__device__ __forceinline__ unsigned xb_add(unsigned* p, unsigned v) { return __hip_atomic_fetch_add(p, v, __ATOMIC_RELAXED, __HIP_MEMORY_SCOPE_AGENT); }
__device__ __forceinline__ unsigned xb_xcc_id() { return (unsigned)__builtin_amdgcn_s_getreg((3 << 11) | 20) & 0xFu; }
#define XB_SPIN(cond, bar) do { unsigned _sp = 0; while (cond) { __builtin_amdgcn_s_sleep(1); \
    if ((++_sp & 255u) == 0u) { if (xb_ld(&(bar)[XB_TMO])) break; if (_sp > XB_SPIN_CAP) { atomicAdd(&(bar)[XB_TMO], 1u); break; } } } } while (0)
struct XcdBarrier { unsigned* bar; unsigned x; volatile LAS unsigned* st; };
__device__ __forceinline__ XcdBarrier xcd_barrier_post(unsigned* bar, volatile LAS unsigned* st) {
    XcdBarrier b; b.bar = bar; b.x = xb_xcc_id(); b.st = st;
    if (threadIdx.x == 0) (void)xb_add(&bar[XB_XCNT(b.x)], 1u);
    return b;
}
__device__ __forceinline__ void xcd_barrier_complete(unsigned* bar, unsigned x, unsigned& nloc, unsigned& nx) {
    const unsigned G = gridDim.x * gridDim.y * gridDim.z;
    unsigned sum, cnt, mine, sp = 0u;
    for (;;) {
        sum = 0u; cnt = 0u; mine = 0u;
#pragma unroll
        for (unsigned j = 0; j < 16; ++j) { const unsigned c = xb_ld(&bar[XB_XCNT(j)]); sum += c; cnt += (c > 0u) ? 1u : 0u; mine = (j == x) ? c : mine; }
        if (sum == G) break;
        __builtin_amdgcn_s_sleep(1);
        if ((++sp & 255u) == 0u) { if (xb_ld(&bar[XB_TMO])) break; if (sp > XB_SPIN_CAP) { atomicAdd(&bar[XB_TMO], 1u); break; } }
    }
    nloc = mine > 0u ? mine : 1u; nx = cnt > 0u ? cnt : 1u;
}
__device__ __forceinline__ void xcd_barrier(const XcdBarrier& b) {
    asm volatile("s_waitcnt vmcnt(0)" ::: "memory");
    __syncthreads();
    if (threadIdx.x == 0) {
        unsigned* bar = b.bar;
        __builtin_amdgcn_s_waitcnt(0);
        unsigned nloc = b.st[0], nx = b.st[1];
        if (nloc == 0u) { xcd_barrier_complete(bar, b.x, nloc, nx); b.st[0] = nloc; b.st[1] = nx; }
        const unsigned old = xb_add(&bar[XB_XSUB(b.x)], 1u);
        const unsigned gen = old / nloc;
        if (old + 1u == (gen + 1u) * nloc) {
            __builtin_amdgcn_fence(__ATOMIC_RELEASE, "agent");
            asm volatile("s_waitcnt vmcnt(0)" ::: "memory");
            const unsigned og = xb_add(&bar[XB_TOP], 1u);
            const unsigned tg = og / nx;
            if (og + 1u == (tg + 1u) * nx) xb_add(&bar[XB_TOPGEN], 1u);
            else XB_SPIN(xb_ld(&bar[XB_TOPGEN]) == tg, bar);
            __builtin_amdgcn_fence(__ATOMIC_ACQUIRE, "agent");
            xb_add(&bar[XB_XGEN(b.x)], 1u);
            asm volatile("s_waitcnt vmcnt(0)" ::: "memory");
        } else {
            XB_SPIN(xb_ld(&bar[XB_XGEN(b.x)]) == gen, bar);
            __builtin_amdgcn_fence(__ATOMIC_ACQUIRE, "agent");
            asm volatile("s_waitcnt vmcnt(0)" ::: "memory");
        }
    }
    __syncthreads();
}

__global__ void __launch_bounds__(512, 2) fwd_kernel(Params p) {
    extern __shared__ __attribute__((aligned(16))) unsigned char shm[];
    LAS unsigned char* lds = (LAS unsigned char*)shm;
    volatile LAS unsigned* xst = (volatile LAS unsigned*)(lds + LDS_BYTES - 16);
    XcdBarrier xb; xb.bar = (unsigned*)(p.ws + WS_BAR); xb.x = 0; xb.st = xst;
    if (p.sync) { if (threadIdx.x == 0) { xst[0] = 0u; xst[1] = 0u; xst[2] = 0u; xst[3] = 0u; } __syncthreads(); xb = xcd_barrier_post((unsigned*)(p.ws + WS_BAR), xst); }
    for (int ph = p.ph_lo; ph < p.ph_hi; ++ph) {
        size_t zoff = 0; asm volatile("" : "+s"(zoff)); unsigned char* ws = p.ws + zoff;
        if (ph == 0) phase_p0(p, lds);
        else if (ph == 1) phase_p1(p);
        else {
            const int l = (ph - 2) / 10, s = (ph - 2) % 10;
            const int nMall = (l == 0) ? MTOT / 256 : NLAT / 256;
            Sched S;
            if (s == 0) {
                GemmP g{(const bf16_t*)(ws + WS_H), (const bf16_t*)(ws + WS_WINT) + (size_t)l * DIN * D, D, D, D, 0, 0};
                if (l == 0) S.init(MTOT / 256, 5, 1, 0, 0, 0, 0); else S.init(NLAT / 256, 5, 1, NCTX / 256, 2, NLAT / 256, 2);
                EpiWin E{(bf16_t*)(ws + WS_Z), (bf16_t*)(ws + WS_USSM)};
                for (int rep = 0; rep < GEMM_REP; ++rep) gemm_phase(lds, g, S, E);
            } else if (s == 1) {
                GemmP g{(const bf16_t*)(ws + WS_USSM), (const bf16_t*)(ws + WS_SMAT) + (size_t)l * 32 * 256 * KS, KY, KS, KS, (size_t)NBC * KY, (size_t)256 * KS};
                S.init(NBC / 256, 1, 32, 0, 0, 0, 0);
                EpiS E{(float*)(ws + WS_S)};
                for (int rep = 0; rep < GEMM_REP; ++rep) gemm_phase(lds, g, S, E);
                __syncthreads();
                for (int rep = 0; rep < MIX_REP; ++rep) { sgu_items(p, l, lds); pool_items(p, l, lds); }
            } else if (s == 2) {
                for (int rep = 0; rep < MIX_REP; ++rep) phase_scan(p, l);
            } else if (s == 3) {
                GemmP g{(const bf16_t*)(ws + WS_USSM), (const bf16_t*)(ws + WS_YMAT) + (size_t)l * 32 * 512 * KY, KY, KY, KY, (size_t)NBC * KY, (size_t)512 * KY};
                S.init(l == 0 ? NBC / 256 : NLAT / TCH / 256, 2, 32, 0, 0, 0, 0);
                EpiY E{(bf16_t*)(ws + WS_Z)};
                for (int rep = 0; rep < GEMM_REP; ++rep) gemm_phase(lds, g, S, E);
            } else if (s == 4) {
                GemmP g{(const bf16_t*)(ws + WS_Z) + 512, (const bf16_t*)(ws + WS_GLUT) + (size_t)l * 512 * 512, DIN, 512, 512, 0, 0};
                S.init(nMall, 2, 1, 0, 0, 0, 0);
                EpiGlu E{(const bf16_t*)(ws + WS_Z), (bf16_t*)(ws + WS_CAT), p.in[23] + (size_t)l * 512};
                for (int rep = 0; rep < GEMM_REP; ++rep) gemm_phase(lds, g, S, E);
            } else if (s == 5) {
                GemmP g{(const bf16_t*)(ws + WS_CAT), (const bf16_t*)(ws + WS_WOUTT) + (size_t)l * D * D, D, D, D, 0, 0};
                S.init(nMall, 4, 1, 0, 0, 0, 0);
                EpiBf E{(bf16_t*)(ws + WS_MOUT), D};
                for (int rep = 0; rep < GEMM_REP; ++rep) gemm_phase(lds, g, S, E);
            } else if (s == 6) {
                phase_post(p, l, 0);
            } else if (s == 7) {
                GemmP g{(const bf16_t*)(ws + WS_H), (const bf16_t*)(ws + WS_WGUT) + (size_t)l * 2 * DFF * D, D, D, D, 0, 0};
                S.init(nMall, 22, 1, 0, 0, 0, 0);
                EpiGU E{(bf16_t*)(ws + WS_HID)};
                for (int rep = 0; rep < GEMM_REP; ++rep) gemm_phase(lds, g, S, E);
            } else if (s == 8) {
                GemmP g{(const bf16_t*)(ws + WS_HID), (const bf16_t*)(ws + WS_WDT) + (size_t)l * D * DFF, DFF, DFF, DFF, 0, 0};
                S.init(nMall, 4, 1, 0, 0, 0, 0);
                EpiBf E{(bf16_t*)(ws + WS_F), D};
                for (int rep = 0; rep < GEMM_REP; ++rep) gemm_phase(lds, g, S, E);
            } else {
                phase_post(p, l, 1);
            }
        }
        if (p.sync && ph + 1 < p.ph_hi) { if (ph == 0) cg::this_grid().sync(); else xcd_barrier(xb); }
    }
}

extern "C" void kernel_launch(void* const* d_in, const int* in_sizes, int n_in, void* d_out, int out_size, void* d_ws, size_t ws_size, hipStream_t stream) {
    static int grid = 0;
    if (grid == 0) {
        if (n_in != 29 || ws_size < WS_END) { fprintf(stderr, "kernel_launch: bad n_in %d or ws %zu < %zu\n", n_in, ws_size, (size_t)WS_END); grid = -1; return; }
        int dev = 0, cus = 0, per_cu = 0;
        hipGetDevice(&dev); hipDeviceGetAttribute(&cus, hipDeviceAttributeMultiprocessorCount, dev);
        if (hipFuncSetAttribute((const void*)fwd_kernel, hipFuncAttributeMaxDynamicSharedMemorySize, LDS_BYTES) != hipSuccess) { fprintf(stderr, "hipFuncSetAttribute failed\n"); grid = -1; return; }
        if (hipOccupancyMaxActiveBlocksPerMultiprocessor(&per_cu, (const void*)fwd_kernel, 512, LDS_BYTES) != hipSuccess || per_cu < 1) per_cu = 1;
        (void)hipGetLastError();
        grid = cus * 1;
    }
    if (grid < 0) return;
    Params p{};
    for (int i = 0; i < 29; ++i) p.in[i] = (const float*)d_in[i];
    p.out = (float*)d_out; p.ws = (unsigned char*)d_ws;
#if ONE_LAUNCH
    if (hipMemsetAsync((char*)d_ws + WS_BAR, 0, XCD_BAR_WORDS * 4, stream) != hipSuccess) { fprintf(stderr, "memset failed\n"); return; }
    p.ph_lo = 0; p.ph_hi = NPH; p.sync = 1;
    void* args[] = {&p};
    hipError_t e = hipLaunchCooperativeKernel((const void*)fwd_kernel, dim3(grid), dim3(512), args, LDS_BYTES, stream);
    if (e != hipSuccess) fprintf(stderr, "cooperative launch failed: %s (grid %d)\n", hipGetErrorString(e), grid);
#else
    for (int ph = 0; ph < NPH; ++ph) {
        p.ph_lo = ph; p.ph_hi = ph + 1; p.sync = 0;
        hipLaunchKernelGGL(fwd_kernel, dim3(grid), dim3(512), LDS_BYTES, stream, p);
    }
#endif
}
```
